# Optimizing an MI355X kernel written in HIP

```python
import jax, jax.numpy as jnp
from jax import lax
import numpy as np

D_MODEL = 1024
BATCH = 2
SEQ = 8192
DEPTH = 4
DEC_BATCH = 32
DEC_SEQ = 8
PAST_LEN = 8192
PAGE_SIZE = 128

POOL_GROUPS = 4
POOL_GC = D_MODEL // 16
POOL_W = POOL_GROUPS * POOL_GC
POOL_WINDOWS = (2, 4, 8, 16)
POOL_HIST = 15
ATT_HD = 64
DIL_GROUPS = ((128, 1), (512, 4), (2048, 16))
ATT_HPG = 2
ATT_HEADS = ATT_HPG * len(DIL_GROUPS)
ATT_W = ATT_HEADS * ATT_HD
ATT_OUT = ATT_HPG * ATT_HD
BAND_BLK = 128
ROPE_THETA = 10000.0
RWKV_HD = 64
RWKV_HEADS = 6
RWKV_W = RWKV_HEADS * RWKV_HD
DECAY_LORA = 64
AAA_LORA = 64
GATE_LORA = 128
RWKV_PROJ = 3 * RWKV_W + DECAY_LORA + AAA_LORA + GATE_LORA
RWKV_LN_EPS = 64e-5
FFN_HIDDEN = -(-8 * D_MODEL // (3 * 256)) * 256
PLE_DIM = 256
RMS_EPS = 1e-6
IN_SIZES = (POOL_W, ATT_W, ATT_W, ATT_W, RWKV_PROJ, D_MODEL, D_MODEL, D_MODEL)
IN_COLS = POOL_W + 3 * ATT_W + RWKV_PROJ + 3 * D_MODEL
RWKV_SIZES = (RWKV_W, RWKV_W, RWKV_W, DECAY_LORA, AAA_LORA, GATE_LORA)

kernel_name = 'hybrid_pool_dilattn_rwkv7_step'


def split_cols(z, sizes):
    offs, acc = [], 0
    for s in sizes[:-1]:
        acc += s
        offs.append(acc)
    return jnp.split(z, offs, axis=-1)


def rms_norm(x, g):
    xf = x.astype(jnp.float32)
    y = xf * lax.rsqrt(jnp.mean(xf * xf, axis=-1, keepdims=True) + RMS_EPS)
    return (y * g.astype(jnp.float32)).astype(x.dtype)


def rope(x, pos):
    C = x.shape[-1]
    half = C // 2
    inv = ROPE_THETA ** (-2.0 * jnp.arange(half, dtype=jnp.float32) / C)
    ang = pos[:, None] * inv[None, :]
    cos = jnp.cos(ang)[None, :, None, :]
    sin = jnp.sin(ang)[None, :, None, :]
    xf = x.astype(jnp.float32)
    x1, x2 = xf[..., :half], xf[..., half:]
    return jnp.concatenate([x1 * cos - x2 * sin, x2 * cos + x1 * sin], axis=-1).astype(x.dtype)


def pool_mix(u_hist, u_new, pos0, w_grp, scale):
    N, T, _ = u_new.shape
    Hh = u_hist.shape[1]
    ext = jnp.concatenate([u_hist.astype(jnp.float32), u_new.astype(jnp.float32)], axis=1)
    cs = jnp.cumsum(ext, axis=1)
    pos = pos0 + jnp.arange(T)
    means = []
    for g, w in enumerate(POOL_WINDOWS):
        c = cs[..., g * POOL_GC:(g + 1) * POOL_GC]
        lag = jnp.pad(c, ((0, 0), (w, 0), (0, 0)))[:, :c.shape[1]]
        win = (c - lag)[:, Hh:]
        cnt = jnp.minimum(pos + 1, w).astype(jnp.float32)
        means.append(win / cnt[None, :, None])
    d = (jnp.concatenate(means, axis=-1) - ext[:, Hh:]).reshape(N, T, POOL_GROUPS, POOL_GC)
    y = jnp.einsum('ntgc,gcd->ntgd', d, w_grp.astype(jnp.float32)).reshape(N, T, POOL_W)
    return y * scale.astype(jnp.float32), ext[:, -POOL_HIST:]


def band_attn(q, k, v, d, span):
    N, S, H, C = q.shape
    L = S // d
    nb = -(-L // BAND_BLK)
    Lp = nb * BAND_BLK

    def stream(x):
        x = x.astype(jnp.float32).reshape(N, L, d, H, C).transpose(0, 2, 1, 3, 4)
        x = jnp.pad(x, ((0, 0), (0, 0), (0, Lp - L), (0, 0), (0, 0)))
        return x.reshape(N, d, nb, BAND_BLK, H, C)

    def with_prev(x):
        prev = jnp.pad(x, ((0, 0), (0, 0), (1, 0), (0, 0), (0, 0), (0, 0)))[:, :, :nb]
        return jnp.concatenate([prev, x], axis=3)

    qs = stream(q)
    ks = with_prev(stream(k))
    vs = with_prev(stream(v))
    s = jnp.einsum('nrbqhc,nrbkhc->nrbhqk', qs, ks) * (C ** -0.5)
    qi = jnp.arange(BAND_BLK)[:, None]
    kj = jnp.arange(2 * BAND_BLK)[None, :]
    dist = BAND_BLK + qi - kj
    kidx = jnp.arange(nb)[:, None, None] * BAND_BLK + kj[None] - BAND_BLK
    mask = (dist >= 0) & (dist <= span) & (kidx >= 0)
    s = jnp.where(mask[None, None, :, None], s, -jnp.inf)
    m = jnp.max(s, axis=-1, keepdims=True)
    e = jnp.exp(s - m)
    den = jnp.sum(e, axis=-1)
    o = jnp.einsum('nrbhqk,nrbkhc->nrbqhc', e, vs) / den.transpose(0, 1, 2, 4, 3)[..., None]
    lse = (m[..., 0] + jnp.log(den)).transpose(0, 1, 2, 4, 3)
    o = o.reshape(N, d, Lp, H, C)[:, :, :L].transpose(0, 2, 1, 3, 4).reshape(N, S, H, C)
    lse = lse.reshape(N, d, Lp, H)[:, :, :L].transpose(0, 2, 1, 3).reshape(N, S, H)
    return o, lse


def gather_attn(q, k_ext, v_ext, hist_len, d, span):
    N, T, H, C = q.shape
    idx = hist_len + jnp.arange(T)[:, None] - d * jnp.arange(span + 1)[None, :]
    valid = idx >= 0
    idx = jnp.maximum(idx, 0)
    kg = k_ext.astype(jnp.float32)[:, idx]
    vg = v_ext.astype(jnp.float32)[:, idx]
    s = jnp.einsum('nthc,ntkhc->nhtk', q.astype(jnp.float32), kg) * (C ** -0.5)
    s = jnp.where(valid[None, None], s, -jnp.inf)
    m = jnp.max(s, axis=-1, keepdims=True)
    e = jnp.exp(s - m)
    den = jnp.sum(e, axis=-1)
    o = jnp.einsum('nhtk,ntkhc->nthc', e, vg) / den.transpose(0, 2, 1)[..., None]
    lse = (m[..., 0] + jnp.log(den)).transpose(0, 2, 1)
    return o, lse


def merge_dilations(outs, lses):
    o = jnp.stack(outs, axis=0)
    w = jax.nn.softmax(jnp.stack(lses, axis=0), axis=0)
    y = jnp.sum(w[..., None] * o, axis=0)
    return y.reshape(y.shape[0], y.shape[1], ATT_OUT)


def rwkv7_mix(zc, shift_prev, S0, lw):
    N, T, _ = zc.shape
    zc = zc.astype(jnp.float32)
    prev = jnp.concatenate([shift_prev.astype(jnp.float32)[:, None], zc[:, :-1]], axis=1)
    zs = zc + (prev - zc) * lw['rwkv_mu'].astype(jnp.float32)
    r, k, v, zw, za, zg = split_cols(zs, RWKV_SIZES)
    w_log = -jax.nn.softplus(-(lw['rwkv_w0'] + jnp.tanh(zw) @ lw['rwkv_w2'])) - 0.5
    decay = jnp.exp(-jnp.exp(w_log.astype(jnp.float32)))
    a = jax.nn.sigmoid((lw['rwkv_a0'] + za @ lw['rwkv_a2']).astype(jnp.float32))
    g = (jax.nn.sigmoid(zg) @ lw['rwkv_g2']).astype(jnp.float32)
    heads = lambda t: t.astype(jnp.float32).reshape(N, T, RWKV_HEADS, RWKV_HD)
    kk = heads(k * lw['rwkv_k_k'])
    kk = kk * lax.rsqrt(jnp.maximum(jnp.sum(kk * kk, axis=-1, keepdims=True), 1e-24))
    k = k * (1.0 + (a - 1.0) * lw['rwkv_k_a'])
    r, k, v, decay, a = (heads(t) for t in (r, k, v, decay, a))

    def step(S, inp):
        r_t, w_t, k_t, v_t, kk_t, a_t = inp
        sa = jnp.einsum('nhvk,nhk->nhv', S, -kk_t)
        S = (S * w_t[:, :, None, :] + sa[..., None] * (kk_t * a_t)[:, :, None, :]
             + v_t[..., None] * k_t[:, :, None, :])
        return S, jnp.einsum('nhvk,nhk->nhv', S, r_t)

    seq = tuple(t.transpose(1, 0, 2, 3) for t in (r, decay, k, v, kk, a))
    S_T, y = lax.scan(step, S0.astype(jnp.float32), seq)
    y = y.transpose(1, 0, 2, 3)
    mu = jnp.mean(y, axis=-1, keepdims=True)
    var = jnp.mean(jnp.square(y - mu), axis=-1, keepdims=True)
    yn = ((y - mu) * lax.rsqrt(var + RWKV_LN_EPS)).reshape(N, T, RWKV_W)
    yn = yn * lw['rwkv_ln_g'].astype(jnp.float32) + lw['rwkv_ln_b'].astype(jnp.float32)
    bonus = (jnp.sum(r * k * lw['rwkv_r_k'].astype(jnp.float32), axis=-1, keepdims=True) * v).reshape(N, T, RWKV_W)
    return (yn + bonus) * g, zc[:, -1], S_T


def decoder_layer(x, p_l, pos0, pool_hist, shift_prev, wkv0, kv_bufs, lw, prompt):
    N, T, _ = x.shape
    h = rms_norm(x, lw['norm_mix_g'])
    z = h @ lw['w_in']
    z_pool, q, k, v, z_rwkv, g_pool, g_attn, g_rwkv = split_cols(z, IN_SIZES)
    y_pool, new_pool = pool_mix(pool_hist, z_pool, pos0, lw['pool_w_grp'], lw['pool_scale'])
    pos = (pos0 + jnp.arange(T)).astype(jnp.float32)
    q = rope(q.reshape(N, T, ATT_HEADS, ATT_HD), pos)
    k = rope(k.reshape(N, T, ATT_HEADS, ATT_HD), pos)
    v = v.reshape(N, T, ATT_HEADS, ATT_HD)
    outs, lses, new_kv = [], [], []
    for gi, (win, dil) in enumerate(DIL_GROUPS):
        hs = slice(gi * ATT_HPG, (gi + 1) * ATT_HPG)
        qg, kg, vg = q[:, :, hs], k[:, :, hs], v[:, :, hs]
        if prompt:
            o, lse = band_attn(qg, kg, vg, dil, win // dil)
            keep = min(win, T)
            new_kv.append(jnp.stack([kg[:, T - keep:], vg[:, T - keep:]], axis=2))
        else:
            buf = kv_bufs[gi]
            hist = buf.shape[1]
            k_ext = jnp.concatenate([buf[:, :, 0].astype(kg.dtype), kg], axis=1)
            v_ext = jnp.concatenate([buf[:, :, 1].astype(vg.dtype), vg], axis=1)
            o, lse = gather_attn(qg, k_ext, v_ext, hist, dil, win // dil)
            keep = min(win, hist + T)
            new_kv.append(jnp.stack([k_ext[:, -keep:], v_ext[:, -keep:]], axis=2))
        outs.append(o)
        lses.append(lse)
    y_attn = merge_dilations(outs, lses)
    y_rwkv, new_shift, new_wkv = rwkv7_mix(z_rwkv, shift_prev, wkv0, lw)
    merged = (jax.nn.sigmoid(g_pool) * (y_pool @ lw['proj_pool'])
              + jax.nn.sigmoid(g_attn) * (y_attn @ lw['proj_attn'])
              + jax.nn.sigmoid(g_rwkv) * (y_rwkv @ lw['proj_rwkv']))
    x = x + (merged @ lw['w_out']).astype(x.dtype)
    h = rms_norm(x, lw['norm_ffn_g'])
    x = x + ((jax.nn.silu(h @ lw['ffn_w1']) * (h @ lw['ffn_w3'])) @ lw['ffn_w2']).astype(x.dtype)
    gate = jax.nn.sigmoid(rms_norm(x, lw['norm_ple_g']) @ lw['ple_gate'])
    x = x + ((p_l @ lw['ple_proj']) * gate).astype(x.dtype)
    return x, (new_pool, new_shift, new_wkv, new_kv)


def setup_inputs(seed: int = 0) -> dict:
    key = jax.random.key(seed)
    ks = iter(jax.random.split(key, 48))
    f32 = jnp.float32

    def nrm(shape, scale=1.0):
        return jax.random.normal(next(ks), shape, f32) * scale

    def gain(shape):
        return 1.0 + 0.02 * jax.random.normal(next(ks), shape, f32)

    L = DEPTH
    kv_len = [min(w, PAST_LEN) for w, _ in DIL_GROUPS]
    return {
        'x_prompt': nrm((BATCH, SEQ, D_MODEL)),
        'x_sample': nrm((DEC_BATCH, DEC_SEQ, D_MODEL)),
        'state_pool': nrm((L, DEC_BATCH, POOL_HIST, POOL_W)),
        'state_shift': nrm((L, DEC_BATCH, RWKV_PROJ)),
        'state_wkv': nrm((L, DEC_BATCH, RWKV_HEADS, RWKV_HD, RWKV_HD), 0.3),
        'cache_kv_w128': nrm((L, DEC_BATCH, kv_len[0], 2, ATT_HPG, ATT_HD)),
        'cache_kv_w512': nrm((L, DEC_BATCH, kv_len[1], 2, ATT_HPG, ATT_HD)),
        'cache_kv_w2048': nrm((L, DEC_BATCH, kv_len[2], 2, ATT_HPG, ATT_HD)),
        'p_prompt': nrm((L, BATCH, SEQ, PLE_DIM)),
        'p_sample': nrm((L, DEC_BATCH, DEC_SEQ, PLE_DIM)),
        'norm_mix_g': gain((L, D_MODEL)),
        'w_in': nrm((L, D_MODEL, IN_COLS), D_MODEL ** -0.5),
        'pool_w_grp': nrm((L, POOL_GROUPS, POOL_GC, POOL_GC), POOL_GC ** -0.5),
        'pool_scale': 1.0 + nrm((L, POOL_W), 0.1),
        'rwkv_mu': jax.random.uniform(next(ks), (L, RWKV_PROJ), f32),
        'rwkv_w0': nrm((L, RWKV_W), 0.5),
        'rwkv_w2': nrm((L, DECAY_LORA, RWKV_W), 0.5 * DECAY_LORA ** -0.5),
        'rwkv_a0': nrm((L, RWKV_W), 0.1),
        'rwkv_a2': nrm((L, AAA_LORA, RWKV_W), AAA_LORA ** -0.5),
        'rwkv_g2': nrm((L, GATE_LORA, RWKV_W), GATE_LORA ** -0.5),
        'rwkv_k_k': 1.0 + nrm((L, RWKV_W), 0.1),
        'rwkv_k_a': 1.0 + nrm((L, RWKV_W), 0.1),
        'rwkv_r_k': nrm((L, RWKV_HEADS, RWKV_HD), 0.1),
        'rwkv_ln_g': gain((L, RWKV_W)),
        'rwkv_ln_b': nrm((L, RWKV_W), 0.02),
        'proj_pool': nrm((L, POOL_W, D_MODEL), POOL_W ** -0.5),
        'proj_attn': nrm((L, ATT_OUT, D_MODEL), ATT_OUT ** -0.5),
        'proj_rwkv': nrm((L, RWKV_W, D_MODEL), RWKV_W ** -0.5),
        'w_out': nrm((L, D_MODEL, D_MODEL), D_MODEL ** -0.5),
        'norm_ffn_g': gain((L, D_MODEL)),
        'ffn_w1': nrm((L, D_MODEL, FFN_HIDDEN), D_MODEL ** -0.5),
        'ffn_w3': nrm((L, D_MODEL, FFN_HIDDEN), D_MODEL ** -0.5),
        'ffn_w2': nrm((L, FFN_HIDDEN, D_MODEL), FFN_HIDDEN ** -0.5),
        'norm_ple_g': gain((L, D_MODEL)),
        'ple_proj': nrm((L, PLE_DIM, D_MODEL), PLE_DIM ** -0.5),
        'ple_gate': nrm((L, D_MODEL, D_MODEL), D_MODEL ** -0.5),
        'norm_final_g': gain((D_MODEL,)),
    }


def reference(x_prompt, x_sample, state_pool, state_shift, state_wkv, cache_kv_w128, cache_kv_w512,
              cache_kv_w2048, p_prompt, p_sample, norm_mix_g, w_in, pool_w_grp, pool_scale, rwkv_mu,
              rwkv_w0, rwkv_w2, rwkv_a0, rwkv_a2, rwkv_g2, rwkv_k_k, rwkv_k_a, rwkv_r_k, rwkv_ln_g,
              rwkv_ln_b, proj_pool, proj_attn, proj_rwkv, w_out, norm_ffn_g, ffn_w1, ffn_w3, ffn_w2,
              norm_ple_g, ple_proj, ple_gate, norm_final_g):
    xp, xs = x_prompt, x_sample
    Np = xp.shape[0]
    pool_p, pool_s, shift_p, shift_s, wkv_p, wkv_s, kv_p, kv_s = [], [], [], [], [], [], [], []
    for i in range(DEPTH):
        lw = {
            'norm_mix_g': norm_mix_g[i], 'w_in': w_in[i], 'pool_w_grp': pool_w_grp[i],
            'pool_scale': pool_scale[i], 'rwkv_mu': rwkv_mu[i], 'rwkv_w0': rwkv_w0[i],
            'rwkv_w2': rwkv_w2[i], 'rwkv_a0': rwkv_a0[i], 'rwkv_a2': rwkv_a2[i], 'rwkv_g2': rwkv_g2[i],
            'rwkv_k_k': rwkv_k_k[i], 'rwkv_k_a': rwkv_k_a[i], 'rwkv_r_k': rwkv_r_k[i],
            'rwkv_ln_g': rwkv_ln_g[i], 'rwkv_ln_b': rwkv_ln_b[i], 'proj_pool': proj_pool[i],
            'proj_attn': proj_attn[i], 'proj_rwkv': proj_rwkv[i], 'w_out': w_out[i],
            'norm_ffn_g': norm_ffn_g[i], 'ffn_w1': ffn_w1[i], 'ffn_w3': ffn_w3[i], 'ffn_w2': ffn_w2[i],
            'norm_ple_g': norm_ple_g[i], 'ple_proj': ple_proj[i], 'ple_gate': ple_gate[i],
        }
        xp, (a_pool, a_shift, a_wkv, a_kv) = decoder_layer(
            xp, p_prompt[i], 0,
            jnp.zeros((Np, 0, POOL_W), xp.dtype),
            jnp.zeros((Np, RWKV_PROJ), jnp.float32),
            jnp.zeros((Np, RWKV_HEADS, RWKV_HD, RWKV_HD), jnp.float32),
            None, lw, True)
        xs, (b_pool, b_shift, b_wkv, b_kv) = decoder_layer(
            xs, p_sample[i], PAST_LEN, state_pool[i], state_shift[i], state_wkv[i],
            (cache_kv_w128[i], cache_kv_w512[i], cache_kv_w2048[i]), lw, False)
        pool_p.append(a_pool); shift_p.append(a_shift); wkv_p.append(a_wkv); kv_p.append(a_kv)
        pool_s.append(b_pool); shift_s.append(b_shift); wkv_s.append(b_wkv); kv_s.append(b_kv)
    y_prompt = rms_norm(xp, norm_final_g)
    y_sample = rms_norm(xs, norm_final_g)
    new_pool_p = jnp.stack(pool_p)
    new_pool_s = jnp.stack(pool_s)
    new_shift_p = jnp.stack(shift_p)
    new_shift_s = jnp.stack(shift_s)
    new_wkv_p = jnp.stack(wkv_p)
    new_wkv_s = jnp.stack(wkv_s)
    kv128_p = jnp.stack([kv[0] for kv in kv_p])
    kv128_s = jnp.stack([kv[0] for kv in kv_s])
    kv512_p = jnp.stack([kv[1] for kv in kv_p])
    kv512_s = jnp.stack([kv[1] for kv in kv_s])
    kv2048_p = jnp.stack([kv[2] for kv in kv_p])
    kv2048_s = jnp.stack([kv[2] for kv in kv_s])
    return (y_prompt, y_sample, new_pool_p, new_pool_s, new_shift_p, new_shift_s, new_wkv_p, new_wkv_s,
            kv128_p, kv128_s, kv512_p, kv512_s, kv2048_p, kv2048_s)
```

```cpp
#include <hip/hip_runtime.h>
#include <hip/hip_cooperative_groups.h>
#include <cstdio>
#include <cstdint>
#include <cstring>
namespace cg = cooperative_groups;

typedef unsigned short u16;
typedef __attribute__((ext_vector_type(8))) short bf16x8;
typedef __attribute__((ext_vector_type(4))) float f32x4;
typedef __attribute__((ext_vector_type(16))) float f32x16;
typedef __attribute__((ext_vector_type(4))) unsigned u32x4;

#define DM 1024
#define MP 16384
#define MS 256
#define MT 16640
#define NMT 130
#define ZW 2816
#define GW 3072
#define NSEG 32
#define SEGLEN 256
#define NTHREADS 256

struct Params {
  const float* in[37];
  float* out;
  float* XF; u16* H; float* Z; u16* G; u16* DP; u16* AL; float* LO; float* SC; float* BON;
  float* YL; float* QT; float* LEND; float* QEND; float* SIN;
  u16* QS_; u16* KS_; u16* VT; float* QSAMP; float* OA; float* LSE;
  u16* MG; u16* HID; u16* PB; float* ROPE;
  u16* W_IN; u16* W_LORA; u16* W_MERGE; u16* W_OUT; u16* W_13; u16* W_2; u16* W_PG; u16* W_PP;
};

#define O_YP 0
#define O_YS 16777216
#define O_POOLP 17039360
#define O_POOLS 17070080
#define O_SHIFTP 17561600
#define O_SHIFTS 17572864
#define O_WKVP 17753088
#define O_WKVS 17949696
#define O_KV128P 21095424
#define O_KV128S 21357568
#define O_KV512P 25551872
#define O_KV512S 26600448
#define O_KV2048P 43377664
#define O_KV2048S 47571968

__device__ __forceinline__ int tid_() { int t = threadIdx.x; asm volatile("" : "+v"(t)); return t; }
__device__ __forceinline__ int bid_() { int b = blockIdx.x; asm volatile("" : "+s"(b)); return b; }
__device__ __forceinline__ u16 f2bf(float f) {
  unsigned u = __float_as_uint(f);
  u += 0x7fffu + ((u >> 16) & 1u);
  return (u16)(u >> 16);
}
__device__ __forceinline__ float bf2f(u16 h) { return __uint_as_float(((unsigned)h) << 16); }
__device__ __forceinline__ float sigmoidf_(float x) { return 1.f / (1.f + __expf(-x)); }
__device__ __forceinline__ float wave_sum(float v) {
#pragma unroll
  for (int o = 32; o >= 1; o >>= 1) v += __shfl_xor(v, o, 64);
  return v;
}

#define LROW 72
#define SMEM_BYTES 40960

template <int NW>
__device__ __forceinline__ void gemm_kloop(const u16* A, int lda, const u16* B, int ldb, int K,
                                           f32x4 (&acc)[4][NW], char* smem) {
  u16* sA = (u16*)smem;
  u16* sB = sA + 128 * LROW;
  const int tid = tid_();
  const int lr = tid >> 3, lc = (tid & 7) * 8;
  const int wid = tid >> 6, lane = tid & 63, wr = wid >> 1, wc = wid & 1, fr = lane & 15, fq = lane >> 4;
  u32x4 ra0, ra1, ra2, ra3, rb0, rb1, rb2, rb3;
  const u16* pa = A + (size_t)lr * lda + lc;
  const u16* pb = B + (size_t)lr * ldb + lc;
  const size_t sa32 = (size_t)32 * lda, sb32 = (size_t)32 * ldb;
  ra0 = *(const u32x4*)(pa); ra1 = *(const u32x4*)(pa + sa32); ra2 = *(const u32x4*)(pa + 2 * sa32); ra3 = *(const u32x4*)(pa + 3 * sa32);
  rb0 = *(const u32x4*)(pb); rb1 = *(const u32x4*)(pb + sb32);
  if (NW == 4) { rb2 = *(const u32x4*)(pb + 2 * sb32); rb3 = *(const u32x4*)(pb + 3 * sb32); }
  const int nt = K >> 6;
#pragma unroll 1
  for (int kt = 0; kt < nt; kt++) {
    __syncthreads();
    *(u32x4*)(sA + (lr)*LROW + lc) = ra0;
    *(u32x4*)(sA + (lr + 32) * LROW + lc) = ra1;
    *(u32x4*)(sA + (lr + 64) * LROW + lc) = ra2;
    *(u32x4*)(sA + (lr + 96) * LROW + lc) = ra3;
    *(u32x4*)(sB + (lr)*LROW + lc) = rb0;
    *(u32x4*)(sB + (lr + 32) * LROW + lc) = rb1;
    if (NW == 4) {
      *(u32x4*)(sB + (lr + 64) * LROW + lc) = rb2;
      *(u32x4*)(sB + (lr + 96) * LROW + lc) = rb3;
    }
    __syncthreads();
    if (kt + 1 < nt) {
      pa += 64; pb += 64;
      ra0 = *(const u32x4*)(pa); ra1 = *(const u32x4*)(pa + sa32); ra2 = *(const u32x4*)(pa + 2 * sa32); ra3 = *(const u32x4*)(pa + 3 * sa32);
      rb0 = *(const u32x4*)(pb); rb1 = *(const u32x4*)(pb + sb32);
      if (NW == 4) { rb2 = *(const u32x4*)(pb + 2 * sb32); rb3 = *(const u32x4*)(pb + 3 * sb32); }
    }
#pragma unroll
    for (int kc = 0; kc < 2; kc++) {
      bf16x8 af[4], bfr[NW];
#pragma unroll
      for (int m = 0; m < 4; m++) af[m] = *(const bf16x8*)(sA + (wr * 64 + m * 16 + fr) * LROW + kc * 32 + fq * 8);
#pragma unroll
      for (int n = 0; n < NW; n++) bfr[n] = *(const bf16x8*)(sB + (wc * 16 * NW + n * 16 + fr) * LROW + kc * 32 + fq * 8);
#pragma unroll
      for (int m = 0; m < 4; m++)
#pragma unroll
        for (int n = 0; n < NW; n++)
          acc[m][n] = __builtin_amdgcn_mfma_f32_16x16x32_bf16(af[m], bfr[n], acc[m][n], 0, 0, 0);
    }
  }
}

template <int NW>
__device__ __forceinline__ void acc_zero(f32x4 (&acc)[4][NW]) {
#pragma unroll
  for (int m = 0; m < 4; m++)
#pragma unroll
    for (int n = 0; n < NW; n++) acc[m][n] = (f32x4){0.f, 0.f, 0.f, 0.f};
}

#define ACC_FOREACH_N(NW, BODY)                                                  \
  {                                                                              \
    const int _tid = tid_(), _wid = _tid >> 6, _lane = _tid & 63;           \
    const int _wr = _wid >> 1, _wc = _wid & 1, _fr = _lane & 15;                 \
    int _fq = _lane >> 4;                                                        \
    asm volatile("" : "+v"(_fq));                                                \
    _Pragma("unroll") for (int m = 0; m < 4; m++) {                              \
    __builtin_amdgcn_sched_barrier(0);                                           \
    _Pragma("unroll") for (int n = 0; n < NW; n++)                               \
    _Pragma("unroll") for (int j = 0; j < 4; j++) {                              \
      const int tr = _wr * 64 + m * 16 + _fq * 4 + j;                            \
      const int tc = _wc * 16 * NW + n * 16 + _fr;                               \
      BODY                                                                       \
    } }                                                                          \
  }
#define ACC_FOREACH(BODY) ACC_FOREACH_N(4, BODY)

__device__ void transpose_w(const float* src, int K, int N, u16* dst, int ldb, int koff, int mode, char* smem) {
  float* t = (float*)smem;
  const int tk = K >> 6, tn = N >> 6;
  const int tid = tid_();
  for (int tile = bid_(); tile < tk * tn; tile += gridDim.x) {
    const int k0 = (tile / tn) * 64, n0 = (tile % tn) * 64;
    __syncthreads();
#pragma unroll
    for (int p = 0; p < 4; p++) {
      int i = (tid >> 4) + 16 * p, j4 = (tid & 15) * 4;
      float4 v = *(const float4*)(src + (size_t)(k0 + i) * N + n0 + j4);
      t[i * 65 + j4] = v.x; t[i * 65 + j4 + 1] = v.y; t[i * 65 + j4 + 2] = v.z; t[i * 65 + j4 + 3] = v.w;
    }
    __syncthreads();
#pragma unroll
    for (int p = 0; p < 2; p++) {
      int n = (tid >> 3) + 32 * p, ks = (tid & 7) * 8;
      unsigned w[4];
#pragma unroll
      for (int q = 0; q < 4; q++) {
        u16 lo = f2bf(t[(ks + 2 * q) * 65 + n]);
        u16 hi = f2bf(t[(ks + 2 * q + 1) * 65 + n]);
        w[q] = (unsigned)lo | ((unsigned)hi << 16);
      }
      int gn = n0 + n;
      int row = gn;
      if (mode == 1) row = (gn >> 4) * 32 + (gn & 15);
      else if (mode == 2) row = (gn >> 4) * 32 + 16 + (gn & 15);
      *(uint4*)(dst + (size_t)row * ldb + koff + k0 + ks) = make_uint4(w[0], w[1], w[2], w[3]);
    }
  }
}

__device__ void phase_prep0(const Params& P, char* smem) {
  const size_t gtid = (size_t)bid_() * NTHREADS + tid_();
  const size_t gsz = (size_t)gridDim.x * NTHREADS;
  {
    const float4* xp = (const float4*)P.in[0];
    const float4* xs = (const float4*)P.in[1];
    float4* xf = (float4*)P.XF;
    const size_t np = (size_t)MP * DM / 4, ns = (size_t)MS * DM / 4;
    for (size_t i = gtid; i < np + ns; i += gsz) xf[i] = (i < np) ? xp[i] : xs[i - np];
  }
  {
    const size_t per = (size_t)MT * 256 / 4;
    for (size_t i = gtid; i < 4 * per; i += gsz) {
      int l = (int)(i / per);
      size_t r = i % per;
      size_t e = r * 4;
      float4 v;
      if (e < (size_t)MP * 256) v = *(const float4*)(P.in[8] + (size_t)l * MP * 256 + e);
      else v = *(const float4*)(P.in[9] + (size_t)l * MS * 256 + (e - (size_t)MP * 256));
      uint2 o;
      o.x = (unsigned)f2bf(v.x) | ((unsigned)f2bf(v.y) << 16);
      o.y = (unsigned)f2bf(v.z) | ((unsigned)f2bf(v.w) << 16);
      *(uint2*)(P.PB + (size_t)l * MT * 256 + e) = o;
    }
  }
  {
    for (int g = 0; g < 3; g++) {
      const int W = (g == 0) ? 128 : (g == 1 ? 512 : 2048);
      const size_t ofs = (g == 0) ? O_KV128S : (g == 1 ? O_KV512S : O_KV2048S);
      const float4* src = (const float4*)P.in[5 + g];
      float4* dst = (float4*)(P.out + ofs);
      const size_t rowsPer = (size_t)(W - 8) * 64;
      const size_t total = 128 * rowsPer;
      for (size_t i = gtid; i < total; i += gsz) {
        size_t ln = i / rowsPer, r = i % rowsPer;
        dst[ln * (size_t)W * 64 + r] = src[ln * (size_t)W * 64 + 8 * 64 + r];
      }
    }
  }
  {
    for (size_t i = gtid; i < 8200 * 32; i += gsz) {
      int pos = (int)(i >> 5), fi = (int)(i & 31);
      float inv = powf(10000.0f, -2.0f * (float)fi / 64.0f);
      float ang = (float)pos * inv;
      double rev = (double)ang * 0.15915494309189533577;
      rev -= rint(rev);
      float rf = (float)rev;
      P.ROPE[i * 2] = __builtin_amdgcn_cosf(rf);
      P.ROPE[i * 2 + 1] = __builtin_amdgcn_sinf(rf);
    }
  }
  for (int l = 0; l < 4; l++) {
    u16* wl = P.W_LORA + (size_t)l * 1152 * 256;
    const float* w2 = P.in[16] + (size_t)l * 64 * 384;
    const float* a2 = P.in[18] + (size_t)l * 64 * 384;
    const float* g2 = P.in[19] + (size_t)l * 128 * 384;
    for (size_t i = gtid; i < 1152 * 256; i += gsz) {
      int k = (int)(i / 1152), n = (int)(i % 1152);
      float v = 0.f;
      if (n < 384) { if (k < 64) v = w2[k * 384 + n]; }
      else if (n < 768) { if (k >= 64 && k < 128) v = a2[(k - 64) * 384 + (n - 384)]; }
      else { if (k >= 128) v = g2[(k - 128) * 384 + (n - 768)]; }
      wl[(size_t)n * 256 + k] = f2bf(v);
    }
    u16* wm = P.W_MERGE + (size_t)l * 1024 * 768;
    const float* wg = P.in[12] + (size_t)l * 4 * 64 * 64;
    const float* sc = P.in[13] + (size_t)l * 256;
    const float* pp = P.in[25] + (size_t)l * 256 * 1024;
    for (size_t i = gtid; i < 256 * 1024; i += gsz) {
      int k = (int)(i >> 10), n = (int)(i & 1023);
      int g = k >> 6, c = k & 63;
      float s = 0.f;
      for (int j = 0; j < 64; j++) s += wg[(g * 64 + c) * 64 + j] * sc[g * 64 + j] * pp[(size_t)(g * 64 + j) * 1024 + n];
      wm[(size_t)n * 768 + k] = f2bf(s);
    }
  }
  for (int l = 0; l < 4; l++) {
    transpose_w(P.in[11] + (size_t)l * 1024 * 5888, 1024, 5888, P.W_IN + (size_t)l * 5888 * 1024, 1024, 0, 0, smem);
    transpose_w(P.in[26] + (size_t)l * 128 * 1024, 128, 1024, P.W_MERGE + (size_t)l * 1024 * 768, 768, 256, 0, smem);
    transpose_w(P.in[27] + (size_t)l * 384 * 1024, 384, 1024, P.W_MERGE + (size_t)l * 1024 * 768, 768, 384, 0, smem);
    transpose_w(P.in[28] + (size_t)l * 1024 * 1024, 1024, 1024, P.W_OUT + (size_t)l * 1024 * 1024, 1024, 0, 0, smem);
    transpose_w(P.in[30] + (size_t)l * 1024 * 2816, 1024, 2816, P.W_13 + (size_t)l * 5632 * 1024, 1024, 0, 1, smem);
    transpose_w(P.in[31] + (size_t)l * 1024 * 2816, 1024, 2816, P.W_13 + (size_t)l * 5632 * 1024, 1024, 0, 2, smem);
    transpose_w(P.in[32] + (size_t)l * 2816 * 1024, 2816, 1024, P.W_2 + (size_t)l * 1024 * 2816, 2816, 0, 0, smem);
    transpose_w(P.in[35] + (size_t)l * 1024 * 1024, 1024, 1024, P.W_PG + (size_t)l * 1024 * 1024, 1024, 0, 0, smem);
    transpose_w(P.in[34] + (size_t)l * 256 * 1024, 256, 1024, P.W_PP + (size_t)l * 1024 * 256, 256, 0, 0, smem);
  }
}

__device__ void phase_rmsnorm(const Params& P, const float* g, bool final_) {
  const int lane = tid_() & 63;
  const int gw = (bid_() * NTHREADS + tid_()) >> 6;
  const int nw = gridDim.x * (NTHREADS / 64);
  for (int m = gw; m < MT; m += nw) {
    const float4* x = (const float4*)(P.XF + (size_t)m * DM);
    float4 v[4];
    float ss = 0.f;
#pragma unroll
    for (int p = 0; p < 4; p++) {
      v[p] = x[p * 64 + lane];
      ss += v[p].x * v[p].x + v[p].y * v[p].y + v[p].z * v[p].z + v[p].w * v[p].w;
    }
    ss = wave_sum(ss);
    float rstd = rsqrtf(ss * (1.f / DM) + 1e-6f);
#pragma unroll
    for (int p = 0; p < 4; p++) {
      float4 gg = ((const float4*)g)[p * 64 + lane];
      float a = v[p].x * rstd * gg.x, b = v[p].y * rstd * gg.y, c = v[p].z * rstd * gg.z, d = v[p].w * rstd * gg.w;
      if (final_) {
        float* o = (m < MP) ? (P.out + O_YP + (size_t)m * DM) : (P.out + O_YS + (size_t)(m - MP) * DM);
        ((float4*)o)[p * 64 + lane] = make_float4(a, b, c, d);
      } else {
        uint2 o;
        o.x = (unsigned)f2bf(a) | ((unsigned)f2bf(b) << 16);
        o.y = (unsigned)f2bf(c) | ((unsigned)f2bf(d) << 16);
        ((uint2*)(P.H + (size_t)m * DM))[p * 64 + lane] = o;
      }
    }
  }
}

__device__ void phase_gemm_in(const Params& P, int l, char* smem) {
  const u16* Bw = P.W_IN + (size_t)l * 5888 * 1024;
  const int NT = 46;
  for (int tile = bid_(); tile < NMT * NT; tile += gridDim.x) {
    const int mt = tile / NT, nt = tile % NT;
    f32x4 acc[4][4];
    acc_zero<4>(acc);
    gemm_kloop<4>(P.H + (size_t)mt * 128 * DM, DM, Bw + (size_t)nt * 128 * 1024, 1024, 1024, acc, smem);
    const int r0 = mt * 128, c0 = nt * 128;
    if (c0 < ZW) {
      ACC_FOREACH({ P.Z[(size_t)(r0 + tr) * ZW + c0 + tc] = acc[m][n][j]; })
    } else {
      ACC_FOREACH({ P.G[(size_t)(r0 + tr) * GW + (c0 - ZW) + tc] = f2bf(sigmoidf_(acc[m][n][j])); })
    }
  }
}

__device__ void phase_gemm_lora(const Params& P, int l, char* smem) {
  const u16* Bw = P.W_LORA + (size_t)l * 1152 * 256;
  const int NT = 9;
  for (int tile = bid_(); tile < NMT * NT; tile += gridDim.x) {
    const int mt = tile / NT, nt = tile % NT;
    f32x4 acc[4][4];
    acc_zero<4>(acc);
    gemm_kloop<4>(P.AL + (size_t)mt * 128 * 256, 256, Bw + (size_t)nt * 128 * 256, 256, 256, acc, smem);
    const int r0 = mt * 128, c0 = nt * 128;
    ACC_FOREACH({ P.LO[(size_t)(r0 + tr) * 1152 + c0 + tc] = acc[m][n][j]; })
  }
}

__device__ void phase_gemm_merge(const Params& P, int l, char* smem) {
  const u16* Bw = P.W_MERGE + (size_t)l * 1024 * 768;
  const int NT = 16;
  for (int tile = bid_(); tile < NMT * NT; tile += gridDim.x) {
    const int mt = tile / NT, nt = tile % NT;
    const int r0 = mt * 128, c0 = nt * 64;
    f32x4 acc[4][2], tot[4][2];
    acc_zero<2>(tot);
    const u16* A = P.DP + (size_t)r0 * 768;
    const u16* B = Bw + (size_t)c0 * 768;
    acc_zero<2>(acc);
    gemm_kloop<2>(A, 768, B, 768, 256, acc, smem);
    asm volatile("" ::: "memory");
    ACC_FOREACH_N(2, { tot[m][n][j] += bf2f(P.G[(size_t)(r0 + tr) * GW + c0 + tc]) * acc[m][n][j]; })
    acc_zero<2>(acc);
    gemm_kloop<2>(A + 256, 768, B + 256, 768, 128, acc, smem);
    asm volatile("" ::: "memory");
    ACC_FOREACH_N(2, { tot[m][n][j] += bf2f(P.G[(size_t)(r0 + tr) * GW + 1024 + c0 + tc]) * acc[m][n][j]; })
    acc_zero<2>(acc);
    gemm_kloop<2>(A + 384, 768, B + 384, 768, 384, acc, smem);
    asm volatile("" ::: "memory");
    ACC_FOREACH_N(2, { tot[m][n][j] += bf2f(P.G[(size_t)(r0 + tr) * GW + 2048 + c0 + tc]) * acc[m][n][j]; })
    asm volatile("" ::: "memory");
    ACC_FOREACH_N(2, { P.MG[(size_t)(r0 + tr) * DM + c0 + tc] = f2bf(tot[m][n][j]); })
  }
}

__device__ void phase_gemm_resid(const Params& P, const u16* A, int lda, const u16* Bw, int K, char* smem) {
  const int NT = 8;
  for (int tile = bid_(); tile < NMT * NT; tile += gridDim.x) {
    const int mt = tile / NT, nt = tile % NT;
    const int r0 = mt * 128, c0 = nt * 128;
    f32x4 acc[4][4];
    acc_zero<4>(acc);
    gemm_kloop<4>(A + (size_t)r0 * lda, lda, Bw + (size_t)c0 * K, K, K, acc, smem);
    ACC_FOREACH({ P.XF[(size_t)(r0 + tr) * DM + c0 + tc] += acc[m][n][j]; })
  }
}

__device__ void phase_gemm_13(const Params& P, int l, char* smem) {
  const u16* Bw = P.W_13 + (size_t)l * 5632 * 1024;
  const int NT = 44;
  for (int tile = bid_(); tile < NMT * NT; tile += gridDim.x) {
    const int mt = tile / NT, nt = tile % NT;
    const int r0 = mt * 128;
    f32x4 acc[4][4];
    acc_zero<4>(acc);
    gemm_kloop<4>(P.H + (size_t)r0 * DM, DM, Bw + (size_t)nt * 128 * 1024, 1024, 1024, acc, smem);
    {
      const int tid = tid_(), wid = tid >> 6, lane = tid & 63;
      const int wr = wid >> 1, wc = wid & 1, fr = lane & 15, fq = lane >> 4;
#pragma unroll
      for (int m = 0; m < 4; m++)
#pragma unroll
        for (int q = 0; q < 2; q++)
#pragma unroll
          for (int j = 0; j < 4; j++) {
            float a = acc[m][2 * q][j], b = acc[m][2 * q + 1][j];
            float h = a * sigmoidf_(a) * b;
            int row = r0 + wr * 64 + m * 16 + fq * 4 + j;
            int col = (nt * 128 + wc * 64) / 2 + q * 16 + fr;
            P.HID[(size_t)row * 2816 + col] = f2bf(h);
          }
    }
  }
}

__device__ void phase_gemm_ple(const Params& P, int l, char* smem) {
  const u16* Bg = P.W_PG + (size_t)l * 1024 * 1024;
  const u16* Bp = P.W_PP + (size_t)l * 1024 * 256;
  const u16* Ap = P.PB + (size_t)l * MT * 256;
  const int NT = 16;
  for (int tile = bid_(); tile < NMT * NT; tile += gridDim.x) {
    const int mt = tile / NT, nt = tile % NT;
    const int r0 = mt * 128, c0 = nt * 64;
    f32x4 acc[4][2], acc2[4][2];
    acc_zero<2>(acc);
    acc_zero<2>(acc2);
    gemm_kloop<2>(P.H + (size_t)r0 * DM, DM, Bg + (size_t)c0 * 1024, 1024, 1024, acc, smem);
    gemm_kloop<2>(Ap + (size_t)r0 * 256, 256, Bp + (size_t)c0 * 256, 256, 256, acc2, smem);
    ACC_FOREACH_N(2, { P.XF[(size_t)(r0 + tr) * DM + c0 + tc] += acc2[m][n][j] * sigmoidf_(acc[m][n][j]); })
  }
}

__device__ __forceinline__ float zs_val(const Params& P, int l, int m, int rc) {
  float zc = P.Z[(size_t)m * ZW + 1408 + rc];
  float prev;
  if (m < MP) {
    int t = m & 8191;
    prev = t ? P.Z[(size_t)(m - 1) * ZW + 1408 + rc] : 0.f;
  } else {
    int ms = m - MP;
    int t = ms & 7;
    prev = t ? P.Z[(size_t)(m - 1) * ZW + 1408 + rc] : P.in[3][(size_t)(l * 32 + (ms >> 3)) * 1408 + rc];
  }
  return zc + (prev - zc) * P.in[14][l * 1408 + rc];
}

__device__ void phase_prep(const Params& P, int l) {
  const size_t gtid = (size_t)bid_() * NTHREADS + tid_();
  const size_t gsz = (size_t)gridDim.x * NTHREADS;
  for (size_t i = gtid; i < (size_t)MT * 256; i += gsz) {
    int m = (int)(i >> 8), c = (int)(i & 255);
    int w = 2 << (c >> 6);
    float u = P.Z[(size_t)m * ZW + c];
    float s = 0.f, cnt;
    if (m < MP) {
      int t = m & 8191;
      int n = (t + 1 < w) ? t + 1 : w;
      for (int j = 0; j < n; j++) s += P.Z[(size_t)(m - j) * ZW + c];
      cnt = (float)n;
    } else {
      int ms = m - MP, t = ms & 7, ns = ms >> 3;
      for (int j = 0; j < w; j++) {
        int idx = 15 + t - j;
        s += (idx >= 15) ? P.Z[(size_t)(m - j) * ZW + c] : P.in[2][((size_t)(l * 32 + ns) * 15 + idx) * 256 + c];
      }
      cnt = (float)w;
    }
    P.DP[(size_t)m * 768 + c] = f2bf(s / cnt - u);
  }
  for (size_t i = gtid; i < 2 * 15 * 256; i += gsz) {
    int c = (int)(i & 255), r = (int)(i >> 8), n = r / 15, ii = r % 15;
    P.out[O_POOLP + ((size_t)(l * 2 + n) * 15 + ii) * 256 + c] = P.Z[(size_t)(n * 8192 + 8177 + ii) * ZW + c];
  }
  for (size_t i = gtid; i < 32 * 15 * 256; i += gsz) {
    int c = (int)(i & 255), r = (int)(i >> 8), n = r / 15, ii = r % 15;
    float v = (ii < 7) ? P.in[2][((size_t)(l * 32 + n) * 15 + 8 + ii) * 256 + c]
                       : P.Z[(size_t)(MP + n * 8 + (ii - 7)) * ZW + c];
    P.out[O_POOLS + ((size_t)(l * 32 + n) * 15 + ii) * 256 + c] = v;
  }
  for (size_t i = gtid; i < (size_t)MT * 192; i += gsz) {
    int m = (int)(i / 192), rr = (int)(i % 192), head = rr >> 5, fi = rr & 31;
    int gi = head >> 1, hh = head & 1;
    int W = (gi == 0) ? 128 : (gi == 1 ? 512 : 2048);
    int dil = (gi == 0) ? 1 : (gi == 1 ? 4 : 16);
    size_t offp = (gi == 0) ? O_KV128P : (gi == 1 ? O_KV512P : O_KV2048P);
    size_t offs = (gi == 0) ? O_KV128S : (gi == 1 ? O_KV512S : O_KV2048S);
    const float* z = P.Z + (size_t)m * ZW;
    int pos, n, t;
    if (m < MP) { n = m >> 13; t = m & 8191; pos = t; }
    else { int ms = m - MP; n = ms >> 3; t = ms & 7; pos = 8192 + t; }
    float cs = P.ROPE[((size_t)pos * 32 + fi) * 2], sn = P.ROPE[((size_t)pos * 32 + fi) * 2 + 1];
    float q1 = z[256 + head * 64 + fi], q2 = z[256 + head * 64 + fi + 32];
    float k1 = z[640 + head * 64 + fi], k2 = z[640 + head * 64 + fi + 32];
    float v1 = z[1024 + head * 64 + fi], v2 = z[1024 + head * 64 + fi + 32];
    float qa = (q1 * cs - q2 * sn) * 0.125f, qb = (q2 * cs + q1 * sn) * 0.125f;
    float ka = k1 * cs - k2 * sn, kb = k2 * cs + k1 * sn;
    if (m < MP) {
      int L = 8192 / dil;
      int sidx = (t % dil) * L + t / dil;
      size_t base = ((size_t)(n * 6 + head) * 8192 + sidx) * 64;
      P.QS_[base + fi] = f2bf(qa); P.QS_[base + fi + 32] = f2bf(qb);
      P.KS_[base + fi] = f2bf(ka); P.KS_[base + fi + 32] = f2bf(kb);
      if (t >= 8192 - W) {
        float* o = P.out + offp + ((size_t)(l * 2 + n) * W + (t - (8192 - W))) * 256;
        o[hh * 64 + fi] = ka; o[hh * 64 + fi + 32] = kb;
        o[128 + hh * 64 + fi] = v1; o[128 + hh * 64 + fi + 32] = v2;
      }
    } else {
      int ms = m - MP;
      float* qs = P.QSAMP + ((size_t)ms * 6 + head) * 64;
      qs[fi] = qa; qs[fi + 32] = qb;
      float* o = P.out + offs + ((size_t)(l * 32 + n) * W + (W - 8 + t)) * 256;
      o[hh * 64 + fi] = ka; o[hh * 64 + fi + 32] = kb;
      o[128 + hh * 64 + fi] = v1; o[128 + hh * 64 + fi + 32] = v2;
    }
  }
  for (size_t i = gtid; i < (size_t)12 * 1024 * 64; i += gsz) {
    int dd = (int)(i & 63);
    int ch = (int)((i >> 6) & 1023);
    int nh = (int)(i >> 16);
    int n = nh / 6, head = nh % 6, gi = head >> 1;
    int dil = (gi == 0) ? 1 : (gi == 1 ? 4 : 16);
    int L = 8192 / dil;
    int s0 = ch * 8;
    int r = s0 / L, l0 = s0 % L;
    unsigned w[4];
#pragma unroll
    for (int q = 0; q < 4; q++) {
      int t0 = (l0 + 2 * q) * dil + r, t1 = (l0 + 2 * q + 1) * dil + r;
      u16 a = f2bf(P.Z[(size_t)(n * 8192 + t0) * ZW + 1024 + head * 64 + dd]);
      u16 b = f2bf(P.Z[(size_t)(n * 8192 + t1) * ZW + 1024 + head * 64 + dd]);
      w[q] = (unsigned)a | ((unsigned)b << 16);
    }
    *(uint4*)(P.VT + ((size_t)nh * 64 + dd) * 8192 + s0) = make_uint4(w[0], w[1], w[2], w[3]);
  }
  for (size_t i = gtid; i < (size_t)MT * 256; i += gsz) {
    int m = (int)(i >> 8), j = (int)(i & 255);
    float zs = zs_val(P, l, m, 1152 + j);
    float v = (j < 64) ? tanhf(zs) : (j < 128 ? zs : sigmoidf_(zs));
    P.AL[i] = f2bf(v);
  }
  for (size_t i = gtid; i < 2 * 1408; i += gsz) {
    int n = (int)(i / 1408), c = (int)(i % 1408);
    P.out[O_SHIFTP + (size_t)(l * 2 + n) * 1408 + c] = P.Z[(size_t)(n * 8192 + 8191) * ZW + 1408 + c];
  }
  for (size_t i = gtid; i < 32 * 1408; i += gsz) {
    int n = (int)(i / 1408), c = (int)(i % 1408);
    P.out[O_SHIFTS + (size_t)(l * 32 + n) * 1408 + c] = P.Z[(size_t)(MP + n * 8 + 7) * ZW + 1408 + c];
  }
}

__device__ void phase_rwkv_prep(const Params& P, int l) {
  const int lane = tid_() & 63;
  const int gw = (bid_() * NTHREADS + tid_()) >> 6;
  const int nw = gridDim.x * (NTHREADS / 64);
  for (int task = gw; task < MT * 6; task += nw) {
    int m = task / 6, h = task % 6;
    int C = h * 64 + lane;
    float r = zs_val(P, l, m, C);
    float k = zs_val(P, l, m, 384 + C);
    float v = zs_val(P, l, m, 768 + C);
    const float* lo = P.LO + (size_t)m * 1152;
    float x = P.in[15][l * 384 + C] + lo[C];
    float nx = -x;
    float sp = fmaxf(nx, 0.f) + log1pf(__expf(-fabsf(nx)));
    float wlog = -sp - 0.5f;
    float decay = __expf(-__expf(wlog));
    float a = sigmoidf_(P.in[17][l * 384 + C] + lo[384 + C]);
    float kk = k * P.in[20][l * 384 + C];
    float ss = wave_sum(kk * kk);
    kk *= rsqrtf(fmaxf(ss, 1e-24f));
    float k2 = k * (1.f + (a - 1.f) * P.in[21][l * 384 + C]);
    float bon = wave_sum(r * k2 * P.in[22][l * 384 + C]);
    float* sc = P.SC + ((size_t)m * 6 + h) * 384;
    sc[lane] = r; sc[64 + lane] = decay; sc[128 + lane] = k2; sc[192 + lane] = kk; sc[256 + lane] = kk * a; sc[320 + lane] = v;
    if (lane == 0) P.BON[(size_t)m * 6 + h] = bon;
  }
}

__device__ __forceinline__ void rwkv_finalize(const Params& P, int l, int m, int h, int lane, float y) {
  int C = h * 64 + lane;
  float mu = wave_sum(y) * (1.f / 64.f);
  float d = y - mu;
  float var = wave_sum(d * d) * (1.f / 64.f);
  float yn = d * rsqrtf(var + 64e-5f) * P.in[23][l * 384 + C] + P.in[24][l * 384 + C];
  float bonus = P.BON[(size_t)m * 6 + h] * P.SC[((size_t)m * 6 + h) * 384 + 320 + lane];
  float g = P.LO[(size_t)m * 1152 + 768 + C];
  P.DP[(size_t)m * 768 + 384 + C] = f2bf((yn + bonus) * g);
}

#define CH 4
template <int KIND>
__device__ void scan_wave(const Params& P, int l, int wt, float* lds) {
  const int lane = tid_() & 63;
  int m0, h, nsteps, nh = 0, seg = 0, ns = 0;
  if (KIND == 2) { ns = wt / 6; h = wt % 6; m0 = MP + ns * 8; nsteps = 8; }
  else { int g = wt >> 1; seg = g & 31; nh = g >> 5; int n = nh / 6; h = nh % 6; m0 = n * 8192 + seg * SEGLEN; nsteps = SEGLEN; }
  float S[64];
  if (KIND == 0) {
#pragma unroll
    for (int k = 0; k < 64; k++) S[k] = 0.f;
  } else if (KIND == 1) {
#pragma unroll
    for (int k = 0; k < 64; k++) S[k] = (k == lane) ? 1.f : 0.f;
  } else {
    const float4* s0 = (const float4*)(P.in[4] + (((size_t)(l * 32 + ns) * 6 + h) * 64 + lane) * 64);
#pragma unroll
    for (int k = 0; k < 16; k++) { float4 v = s0[k]; S[4 * k] = v.x; S[4 * k + 1] = v.y; S[4 * k + 2] = v.z; S[4 * k + 3] = v.w; }
  }
  f32x4 stg[6];
  const int nch = nsteps / CH;
  {
    const float* src = P.SC + ((size_t)m0 * 6 + h) * 384;
#pragma unroll
    for (int q = 0; q < 6; q++) {
      int e = q * 64 + lane; int st = e / 96, w = e % 96;
      stg[q] = *(const f32x4*)(src + (size_t)st * 2304 + w * 4);
    }
  }
  for (int c = 0; c < nch; c++) {
#pragma unroll
    for (int q = 0; q < 6; q++) ((f32x4*)lds)[q * 64 + lane] = stg[q];
    if (c + 1 < nch) {
      const float* src = P.SC + ((size_t)(m0 + (c + 1) * CH) * 6 + h) * 384;
#pragma unroll
      for (int q = 0; q < 6; q++) {
        int e = q * 64 + lane; int st = e / 96, w = e % 96;
        stg[q] = *(const f32x4*)(src + (size_t)st * 2304 + w * 4);
      }
    }
#pragma unroll 1
    for (int s = 0; s < CH; s++) {
      const float4* o = (const float4*)(lds + s * 384);
      const int m = m0 + c * CH + s;
      float sa = 0.f;
#pragma unroll
      for (int k = 0; k < 16; k++) {
        float4 kk = o[48 + k];
        sa -= S[4 * k] * kk.x; sa -= S[4 * k + 1] * kk.y; sa -= S[4 * k + 2] * kk.z; sa -= S[4 * k + 3] * kk.w;
      }
      float vv = 0.f;
      if (KIND != 1) vv = lds[s * 384 + 320 + lane];
      float y = 0.f;
#pragma unroll
      for (int k = 0; k < 16; k++) {
        float4 w = o[16 + k], b = o[64 + k], r = o[k];
        if (KIND != 1) {
          float4 kv = o[32 + k];
          S[4 * k] = S[4 * k] * w.x + (sa * b.x + vv * kv.x);
          S[4 * k + 1] = S[4 * k + 1] * w.y + (sa * b.y + vv * kv.y);
          S[4 * k + 2] = S[4 * k + 2] * w.z + (sa * b.z + vv * kv.z);
          S[4 * k + 3] = S[4 * k + 3] * w.w + (sa * b.w + vv * kv.w);
        } else {
          S[4 * k] = S[4 * k] * w.x + sa * b.x;
          S[4 * k + 1] = S[4 * k + 1] * w.y + sa * b.y;
          S[4 * k + 2] = S[4 * k + 2] * w.z + sa * b.z;
          S[4 * k + 3] = S[4 * k + 3] * w.w + sa * b.w;
        }
        y += S[4 * k] * r.x; y += S[4 * k + 1] * r.y; y += S[4 * k + 2] * r.z; y += S[4 * k + 3] * r.w;
      }
      if (KIND == 0) P.YL[(size_t)m * 384 + h * 64 + lane] = y;
      else if (KIND == 1) P.QT[(size_t)m * 384 + h * 64 + lane] = y;
      else rwkv_finalize(P, l, m, h, lane, y);
    }
  }
  float* dst;
  if (KIND == 0) dst = P.LEND + ((size_t)(nh * NSEG + seg) * 64 + lane) * 64;
  else if (KIND == 1) dst = P.QEND + ((size_t)(nh * NSEG + seg) * 64 + lane) * 64;
  else dst = P.out + O_WKVS + (((size_t)(l * 32 + ns) * 6 + h) * 64 + lane) * 64;
#pragma unroll
  for (int k = 0; k < 16; k++) ((float4*)dst)[k] = make_float4(S[4 * k], S[4 * k + 1], S[4 * k + 2], S[4 * k + 3]);
}

__device__ void attn_prompt_wave(const Params& P, int task) {
  const int lane = tid_() & 63, c = lane & 31, hi = lane >> 5;
  const int qb = task & 255, nh = task >> 8;
  const int n = nh / 6, head = nh % 6, gi = head >> 1;
  const int dil = (gi == 0) ? 1 : (gi == 1 ? 4 : 16);
  const int L = 8192 / dil;
  const int sidx0 = qb * 32, r = sidx0 / L, l0 = sidx0 % L;
  const u16* Kb = P.KS_ + (size_t)nh * 8192 * 64;
  const u16* Qb = P.QS_ + (size_t)nh * 8192 * 64;
  const u16* Vb = P.VT + (size_t)nh * 64 * 8192;
  bf16x8 qf[4];
#pragma unroll
  for (int ch = 0; ch < 4; ch++) qf[ch] = *(const bf16x8*)(Qb + (size_t)(sidx0 + c) * 64 + ch * 16 + hi * 8);
  f32x16 o0, o1;
#pragma unroll
  for (int i = 0; i < 16; i++) { o0[i] = 0.f; o1[i] = 0.f; }
  float mrun = -INFINITY, lrun = 0.f;
  for (int kt = 0; kt < 5; kt++) {
    const int kl0 = l0 - 128 + kt * 32;
    if (kl0 < 0) continue;
    const int ks0 = r * L + kl0;
    f32x16 s;
#pragma unroll
    for (int i = 0; i < 16; i++) s[i] = 0.f;
#pragma unroll
    for (int ch = 0; ch < 4; ch++) {
      bf16x8 kf = *(const bf16x8*)(Kb + (size_t)(ks0 + c) * 64 + ch * 16 + hi * 8);
      s = __builtin_amdgcn_mfma_f32_32x32x16_bf16(kf, qf[ch], s, 0, 0, 0);
    }
    if (kt == 4) {
#pragma unroll
      for (int i = 0; i < 16; i++) { int key = (i >> 2) * 8 + hi * 4 + (i & 3); if (key > c) s[i] = -INFINITY; }
    }
    if (kt == 0) {
#pragma unroll
      for (int i = 0; i < 16; i++) { int key = (i >> 2) * 8 + hi * 4 + (i & 3); if (key < c) s[i] = -INFINITY; }
    }
    float mx = s[0];
#pragma unroll
    for (int i = 1; i < 16; i++) mx = fmaxf(mx, s[i]);
    mx = fmaxf(mx, __shfl_xor(mx, 32, 64));
    const float mnew = fmaxf(mrun, mx);
    const float alpha = __expf(mrun - mnew);
    float p[16];
    float ps = 0.f;
#pragma unroll
    for (int i = 0; i < 16; i++) { p[i] = __expf(s[i] - mnew); ps += p[i]; }
    ps += __shfl_xor(ps, 32, 64);
    lrun = lrun * alpha + ps;
    mrun = mnew;
#pragma unroll
    for (int i = 0; i < 16; i++) { o0[i] *= alpha; o1[i] *= alpha; }
#pragma unroll
    for (int j = 0; j < 2; j++) {
      bf16x8 pf;
#pragma unroll
      for (int i = 0; i < 8; i++) pf[i] = (short)f2bf(p[8 * j + i]);
#pragma unroll
      for (int dt = 0; dt < 2; dt++) {
        const u16* vp = Vb + (size_t)(dt * 32 + c) * 8192 + ks0 + 16 * j + hi * 4;
        uint2 v0 = *(const uint2*)vp;
        uint2 v1 = *(const uint2*)(vp + 8);
        union { uint4 u; bf16x8 b; } cv;
        cv.u = make_uint4(v0.x, v0.y, v1.x, v1.y);
        if (dt == 0) o0 = __builtin_amdgcn_mfma_f32_32x32x16_bf16(cv.b, pf, o0, 0, 0, 0);
        else o1 = __builtin_amdgcn_mfma_f32_32x32x16_bf16(cv.b, pf, o1, 0, 0, 0);
      }
    }
  }
  const float inv = 1.f / lrun;
  const int lq = l0 + c;
  const int t = lq * dil + r;
  const int m = n * 8192 + t;
  float* od = P.OA + ((size_t)m * 6 + head) * 64;
#pragma unroll
  for (int g4 = 0; g4 < 4; g4++) {
    *(float4*)(od + g4 * 8 + hi * 4) = make_float4(o0[4 * g4] * inv, o0[4 * g4 + 1] * inv, o0[4 * g4 + 2] * inv, o0[4 * g4 + 3] * inv);
    *(float4*)(od + 32 + g4 * 8 + hi * 4) = make_float4(o1[4 * g4] * inv, o1[4 * g4 + 1] * inv, o1[4 * g4 + 2] * inv, o1[4 * g4 + 3] * inv);
  }
  if (hi == 0) P.LSE[(size_t)m * 6 + head] = mrun + __logf(lrun);
}

__device__ void attn_sample_wave(const Params& P, int l, int task) {
  const int lane = tid_() & 63;
  const int head = task % 6, ms = task / 6, t = ms & 7, ns = ms >> 3;
  const int gi = head >> 1, hh = head & 1;
  const int W = (gi == 0) ? 128 : (gi == 1 ? 512 : 2048);
  const int dil = (gi == 0) ? 1 : (gi == 1 ? 4 : 16);
  const size_t offs = (gi == 0) ? O_KV128S : (gi == 1 ? O_KV512S : O_KV2048S);
  const float* cache = P.in[5 + gi] + ((size_t)(l * 32 + ns) * W) * 256;
  const float* outkv = P.out + offs + ((size_t)(l * 32 + ns) * W) * 256;
  const float q = P.QSAMP[((size_t)ms * 6 + head) * 64 + lane];
  float mrun = -INFINITY, lrun = 0.f, o = 0.f;
  for (int j = 0; j <= 128; j++) {
    int idx = W + t - dil * j;
    const float* row = (idx >= W) ? (outkv + (size_t)(idx - 8) * 256) : (cache + (size_t)idx * 256);
    float kx = row[hh * 64 + lane], vx = row[128 + hh * 64 + lane];
    float s = wave_sum(q * kx);
    float mnew = fmaxf(mrun, s);
    float alpha = __expf(mrun - mnew), p = __expf(s - mnew);
    lrun = lrun * alpha + p;
    o = o * alpha + p * vx;
    mrun = mnew;
  }
  const int m = MP + ms;
  P.OA[((size_t)m * 6 + head) * 64 + lane] = o / lrun;
  if (lane == 0) P.LSE[(size_t)m * 6 + head] = mrun + __logf(lrun);
}

__device__ void phase_scan_attn(const Params& P, int l, char* smem) {
  const int wid = tid_() >> 6;
  float* lds = (float*)smem + wid * (CH * 384);
  const int NB = 192 + 48 + 768 + 384;
  for (int bt = bid_(); bt < NB; bt += gridDim.x) {
    if (bt < 192) {
      int wt = bt * 4 + wid;
      if (wt & 1) scan_wave<1>(P, l, wt, lds); else scan_wave<0>(P, l, wt, lds);
    } else if (bt < 240) {
      scan_wave<2>(P, l, (bt - 192) * 4 + wid, lds);
    } else if (bt < 240 + 768) {
      attn_prompt_wave(P, (bt - 240) * 4 + wid);
    } else {
      attn_sample_wave(P, l, (bt - 1008) * 4 + wid);
    }
  }
}

__device__ void phase_combine(const Params& P, int l, char* smem) {
  if (bid_() < 12) {
    const int nh = bid_();
    float* sS = (float*)smem;
    float* sQ = sS + 64 * 65;
    const int tid = tid_(), v = tid >> 2, kq = tid & 3;
    float cur[16];
#pragma unroll
    for (int i = 0; i < 16; i++) cur[i] = 0.f;
    for (int seg = 0; seg < NSEG; seg++) {
      float* sin = P.SIN + ((size_t)(nh * NSEG + seg) * 64 + v) * 64 + kq * 16;
#pragma unroll
      for (int i = 0; i < 4; i++) ((float4*)sin)[i] = make_float4(cur[4 * i], cur[4 * i + 1], cur[4 * i + 2], cur[4 * i + 3]);
      __syncthreads();
#pragma unroll
      for (int i = 0; i < 16; i++) sS[v * 65 + kq * 16 + i] = cur[i];
      const float4* qe = (const float4*)(P.QEND + (size_t)(nh * NSEG + seg) * 4096);
#pragma unroll
      for (int i = 0; i < 4; i++) ((float4*)sQ)[i * 256 + tid] = qe[i * 256 + tid];
      __syncthreads();
      const float* le = P.LEND + ((size_t)(nh * NSEG + seg) * 64 + v) * 64 + kq * 16;
      float nx[16];
#pragma unroll
      for (int i = 0; i < 4; i++) { float4 t4 = ((const float4*)le)[i]; nx[4 * i] = t4.x; nx[4 * i + 1] = t4.y; nx[4 * i + 2] = t4.z; nx[4 * i + 3] = t4.w; }
      for (int j = 0; j < 64; j++) {
        float a = sS[v * 65 + j];
        const float4* qr = (const float4*)(sQ + j * 64 + kq * 16);
#pragma unroll
        for (int i = 0; i < 4; i++) {
          float4 q4 = qr[i];
          nx[4 * i] += a * q4.x; nx[4 * i + 1] += a * q4.y; nx[4 * i + 2] += a * q4.z; nx[4 * i + 3] += a * q4.w;
        }
      }
#pragma unroll
      for (int i = 0; i < 16; i++) cur[i] = nx[i];
    }
    float* dst = P.out + O_WKVP + (((size_t)l * 12 + nh) * 64 + v) * 64 + kq * 16;
#pragma unroll
    for (int i = 0; i < 4; i++) ((float4*)dst)[i] = make_float4(cur[4 * i], cur[4 * i + 1], cur[4 * i + 2], cur[4 * i + 3]);
  } else {
    const size_t gtid = (size_t)(bid_() - 12) * NTHREADS + tid_();
    const size_t gsz = (size_t)(gridDim.x - 12) * NTHREADS;
    for (size_t i = gtid; i < (size_t)MT * 128; i += gsz) {
      int m = (int)(i >> 7), hh = (int)((i >> 6) & 1), dd = (int)(i & 63);
      float l0 = P.LSE[(size_t)m * 6 + hh], l1 = P.LSE[(size_t)m * 6 + 2 + hh], l2 = P.LSE[(size_t)m * 6 + 4 + hh];
      float mx = fmaxf(l0, fmaxf(l1, l2));
      float w0 = __expf(l0 - mx), w1 = __expf(l1 - mx), w2 = __expf(l2 - mx);
      float inv = 1.f / (w0 + w1 + w2);
      const float* oa = P.OA + (size_t)m * 384;
      float y = (w0 * oa[hh * 64 + dd] + w1 * oa[(2 + hh) * 64 + dd] + w2 * oa[(4 + hh) * 64 + dd]) * inv;
      P.DP[(size_t)m * 768 + 256 + hh * 64 + dd] = f2bf(y);
    }
  }
}

__device__ void phase_correct(const Params& P, int l) {
  const int lane = tid_() & 63;
  const int gw = (bid_() * NTHREADS + tid_()) >> 6;
  const int nw = gridDim.x * (NTHREADS / 64);
  for (int task = gw; task < 12 * NSEG * 4; task += nw) {
    const int qtr = task & 3, g = task >> 2, seg = g & 31, nh = g >> 5, n = nh / 6, h = nh % 6;
    float S[64];
    const float4* sp = (const float4*)(P.SIN + ((size_t)(nh * NSEG + seg) * 64 + lane) * 64);
#pragma unroll
    for (int k = 0; k < 16; k++) { float4 v = sp[k]; S[4 * k] = v.x; S[4 * k + 1] = v.y; S[4 * k + 2] = v.z; S[4 * k + 3] = v.w; }
    const int m0 = n * 8192 + seg * SEGLEN + qtr * 64;
    for (int s = 0; s < 64; s++) {
      const int m = m0 + s;
      const float4* q = (const float4*)(P.QT + (size_t)m * 384 + h * 64);
      float y = P.YL[(size_t)m * 384 + h * 64 + lane];
#pragma unroll
      for (int k = 0; k < 16; k++) {
        float4 q4 = q[k];
        y += S[4 * k] * q4.x; y += S[4 * k + 1] * q4.y; y += S[4 * k + 2] * q4.z; y += S[4 * k + 3] * q4.w;
      }
      rwkv_finalize(P, l, m, h, lane, y);
    }
  }
}

__global__ void __launch_bounds__(NTHREADS, 2) fwd_megakernel(Params P) {
  cg::grid_group grid = cg::this_grid();
  __shared__ __attribute__((aligned(16))) char smem[SMEM_BYTES];
  phase_prep0(P, smem);
  grid.sync();
  for (int l = 0; l < 4; l++) {
    phase_rmsnorm(P, P.in[10] + l * DM, false);
    grid.sync();
    phase_gemm_in(P, l, smem);
    grid.sync();
    phase_prep(P, l);
    grid.sync();
    phase_gemm_lora(P, l, smem);
    grid.sync();
    phase_rwkv_prep(P, l);
    grid.sync();
    phase_scan_attn(P, l, smem);
    grid.sync();
    phase_combine(P, l, smem);
    grid.sync();
    phase_correct(P, l);
    grid.sync();
    phase_gemm_merge(P, l, smem);
    grid.sync();
    phase_gemm_resid(P, P.MG, DM, P.W_OUT + (size_t)l * 1024 * 1024, 1024, smem);
    grid.sync();
    phase_rmsnorm(P, P.in[29] + l * DM, false);
    grid.sync();
    phase_gemm_13(P, l, smem);
    grid.sync();
    phase_gemm_resid(P, P.HID, 2816, P.W_2 + (size_t)l * 1024 * 2816, 2816, smem);
    grid.sync();
    phase_rmsnorm(P, P.in[33] + l * DM, false);
    grid.sync();
    phase_gemm_ple(P, l, smem);
    grid.sync();
  }
  phase_rmsnorm(P, P.in[36], true);
}

extern "C" void kernel_launch(void* const* d_in, const int* in_sizes, int n_in, void* d_out, int out_size,
                              void* d_ws, size_t ws_size, hipStream_t stream) {
  static int grid_blocks = 0;
  if (!grid_blocks) {
    int dev = 0, cus = 0, per_cu = 0;
    hipGetDevice(&dev);
    hipDeviceGetAttribute(&cus, hipDeviceAttributeMultiprocessorCount, dev);
    hipOccupancyMaxActiveBlocksPerMultiprocessor(&per_cu, fwd_megakernel, NTHREADS, 0);
    if (per_cu > 2) per_cu = 2;
    if (per_cu < 1) per_cu = 1;
    grid_blocks = cus * per_cu;
  }
  Params P;
  memset(&P, 0, sizeof(P));
  for (int i = 0; i < 37; i++) P.in[i] = (const float*)d_in[i];
  P.out = (float*)d_out;
  char* w = (char*)d_ws;
  size_t off = 0;
  auto take = [&](size_t bytes) { char* p = w + off; off += (bytes + 255) & ~(size_t)255; return p; };
  P.XF = (float*)take((size_t)MT * DM * 4);
  P.H = (u16*)take((size_t)MT * DM * 2);
  P.Z = (float*)take((size_t)MT * ZW * 4);
  P.HID = (u16*)P.Z;
  P.G = (u16*)take((size_t)MT * GW * 2);
  P.DP = (u16*)take((size_t)MT * 768 * 2);
  P.AL = (u16*)take((size_t)MT * 256 * 2);
  P.LO = (float*)take((size_t)MT * 1152 * 4);
  P.SC = (float*)take((size_t)MT * 2304 * 4);
  P.BON = (float*)take((size_t)MT * 6 * 4);
  P.YL = (float*)take((size_t)MP * 384 * 4);
  P.QT = (float*)take((size_t)MP * 384 * 4);
  P.LEND = (float*)take((size_t)12 * NSEG * 4096 * 4);
  P.QEND = (float*)take((size_t)12 * NSEG * 4096 * 4);
  P.SIN = (float*)take((size_t)12 * NSEG * 4096 * 4);
  P.QS_ = (u16*)take((size_t)MP * 384 * 2);
  P.KS_ = (u16*)take((size_t)MP * 384 * 2);
  P.VT = (u16*)take((size_t)MP * 384 * 2);
  P.QSAMP = (float*)take((size_t)MS * 384 * 4);
  P.OA = (float*)take((size_t)MT * 384 * 4);
  P.LSE = (float*)take((size_t)MT * 6 * 4);
  P.MG = (u16*)take((size_t)MT * DM * 2);
  P.PB = (u16*)take((size_t)4 * MT * 256 * 2);
  P.ROPE = (float*)take((size_t)8200 * 64 * 4);
  P.W_IN = (u16*)take((size_t)4 * 5888 * 1024 * 2);
  P.W_LORA = (u16*)take((size_t)4 * 1152 * 256 * 2);
  P.W_MERGE = (u16*)take((size_t)4 * 1024 * 768 * 2);
  P.W_OUT = (u16*)take((size_t)4 * 1024 * 1024 * 2);
  P.W_13 = (u16*)take((size_t)4 * 5632 * 1024 * 2);
  P.W_2 = (u16*)take((size_t)4 * 1024 * 2816 * 2);
  P.W_PG = (u16*)take((size_t)4 * 1024 * 1024 * 2);
  P.W_PP = (u16*)take((size_t)4 * 1024 * 256 * 2);
  if (off > ws_size) { fprintf(stderr, "workspace too small: need %zu have %zu\n", off, ws_size); return; }
  void* args[] = {&P};
  hipError_t e = hipLaunchCooperativeKernel((void*)fwd_megakernel, dim3(grid_blocks), dim3(NTHREADS), args, 0, stream);
  if (e != hipSuccess) fprintf(stderr, "cooperative launch failed: %s (grid %d)\n", hipGetErrorString(e), grid_blocks);
}
```

```cpp
#include <hip/hip_runtime.h>
#include <hip/hip_cooperative_groups.h>
#include <cstdio>
#include <cstdint>
#include <cstring>
namespace cg = cooperative_groups;

typedef unsigned short u16;
typedef __attribute__((ext_vector_type(8))) short bf16x8;
typedef __attribute__((ext_vector_type(4))) float f32x4;
typedef __attribute__((ext_vector_type(16))) float f32x16;
typedef __attribute__((ext_vector_type(4))) unsigned u32x4;

#define DM 1024
#define MP 16384
#define MS 256
#define MT 16640
#define NMT 130
#define ZW 2816
#define GW 3072
#define NSEG 32
#define SEGLEN 256
#define NTHREADS 512
#define DPW 896
#define LOW 1280

struct Params {
  const float* in[37];
  float* out;
  char* ws;
};
constexpr size_t al256(size_t x) { return (x + 255) & ~(size_t)255; }
constexpr size_t OFF_XF = 0;
constexpr size_t OFF_H = OFF_XF + al256((size_t)MT*DM*4);
constexpr size_t OFF_Z = OFF_H + al256((size_t)MT*DM*2);
constexpr size_t OFF_G = OFF_Z + al256((size_t)MT*ZW*4);
constexpr size_t OFF_DP = OFF_G + al256((size_t)MT*GW*2);
constexpr size_t OFF_AL = OFF_DP + al256((size_t)MT*DPW*2);
constexpr size_t OFF_LO = OFF_AL + al256((size_t)MT*256*2);
constexpr size_t OFF_SC = OFF_LO + al256((size_t)MT*LOW*4);
constexpr size_t OFF_BON = OFF_SC + al256((size_t)MT*2304*4);
constexpr size_t OFF_YL = OFF_BON + al256((size_t)MT*6*4);
constexpr size_t OFF_QT = OFF_YL + al256((size_t)MP*384*4);
constexpr size_t OFF_LEND = OFF_QT + al256((size_t)MP*384*4);
constexpr size_t OFF_QEND = OFF_LEND + al256((size_t)12*NSEG*4096*4);
constexpr size_t OFF_SIN = OFF_QEND + al256((size_t)12*NSEG*4096*4);
constexpr size_t OFF_QS_ = OFF_SIN + al256((size_t)12*NSEG*4096*4);
constexpr size_t OFF_KS_ = OFF_QS_ + al256((size_t)MP*384*2);
constexpr size_t OFF_VT = OFF_KS_ + al256((size_t)MP*384*2);
constexpr size_t OFF_QSAMP = OFF_VT + al256((size_t)MP*384*2);
constexpr size_t OFF_OA = OFF_QSAMP + al256((size_t)MS*384*4);
constexpr size_t OFF_LSE = OFF_OA + al256((size_t)MT*384*4);
constexpr size_t OFF_MG = OFF_LSE + al256((size_t)MT*6*4);
constexpr size_t OFF_PB = OFF_MG + al256((size_t)MT*DM*2);
constexpr size_t OFF_ROPE = OFF_PB + al256((size_t)4*MT*256*2);
constexpr size_t OFF_W_IN = OFF_ROPE + al256((size_t)8200*64*4);
constexpr size_t OFF_W_LORA = OFF_W_IN + al256((size_t)4*5888*1024*2);
constexpr size_t OFF_W_MERGE = OFF_W_LORA + al256((size_t)4*LOW*256*2);
constexpr size_t OFF_W_OUT = OFF_W_MERGE + al256((size_t)4*1024*DPW*2);
constexpr size_t OFF_W_13 = OFF_W_OUT + al256((size_t)4*1024*1024*2);
constexpr size_t OFF_W_2 = OFF_W_13 + al256((size_t)4*5632*1024*2);
constexpr size_t OFF_W_PG = OFF_W_2 + al256((size_t)4*1024*2816*2);
constexpr size_t OFF_W_PP = OFF_W_PG + al256((size_t)4*1024*1024*2);
constexpr size_t WS_TOTAL = OFF_W_PP + al256((size_t)4*1024*256*2);
constexpr size_t OFF_HID = OFF_Z, OFF_T = OFF_Z, OFF_PG = OFF_Z + (size_t)100 * 1024 * 1024;


#define O_YP 0
#define O_YS 16777216
#define O_POOLP 17039360
#define O_POOLS 17070080
#define O_SHIFTP 17561600
#define O_SHIFTS 17572864
#define O_WKVP 17753088
#define O_WKVS 17949696
#define O_KV128P 21095424
#define O_KV128S 21357568
#define O_KV512P 25551872
#define O_KV512S 26600448
#define O_KV2048P 43377664
#define O_KV2048S 47571968

__device__ __forceinline__ int tid_() { int t = threadIdx.x; asm volatile("" : "+v"(t)); return t; }
__device__ __forceinline__ int bid_() { int b = blockIdx.x; asm volatile("" : "+s"(b)); return b; }
__device__ __forceinline__ u16 f2bf(float f) {
  unsigned u = __float_as_uint(f);
  u += 0x7fffu + ((u >> 16) & 1u);
  return (u16)(u >> 16);
}
__device__ __forceinline__ float bf2f(u16 h) { return __uint_as_float(((unsigned)h) << 16); }
__device__ __forceinline__ float sigmoidf_(float x) { return 1.f / (1.f + __expf(-x)); }
__device__ __forceinline__ float dpp_add_(float v, const int ctrl_sel) {
  int iv = __float_as_int(v), r;
  if (ctrl_sel == 0) r = __builtin_amdgcn_update_dpp(0, iv, 0xB1, 0xF, 0xF, true);
  else if (ctrl_sel == 1) r = __builtin_amdgcn_update_dpp(0, iv, 0x4E, 0xF, 0xF, true);
  else if (ctrl_sel == 2) r = __builtin_amdgcn_update_dpp(0, iv, 0x141, 0xF, 0xF, true);
  else r = __builtin_amdgcn_update_dpp(0, iv, 0x140, 0xF, 0xF, true);
  return v + __int_as_float(r);
}
__device__ __forceinline__ float wave_sum(float v) {
  v = dpp_add_(v, 0); v = dpp_add_(v, 1); v = dpp_add_(v, 2); v = dpp_add_(v, 3);
  int iv = __float_as_int(v);
  float a = __int_as_float(__builtin_amdgcn_readlane(iv, 0)), b = __int_as_float(__builtin_amdgcn_readlane(iv, 16));
  float c = __int_as_float(__builtin_amdgcn_readlane(iv, 32)), d = __int_as_float(__builtin_amdgcn_readlane(iv, 48));
  return (a + b) + (c + d);
}
__device__ __forceinline__ float xor32_(float v, int lane) {
  return __int_as_float(__builtin_amdgcn_ds_bpermute((lane ^ 32) << 2, __float_as_int(v)));
}

#define LROW 72
#define SMEM_BYTES 131072
namespace pg8 {
#define PG8_LAS __attribute__((address_space(3)))
typedef unsigned short bf16_t;
constexpr int BM = 256, BK = 64, HALF = 128, HTB = HALF * BK * 2  , STAGE_BYTES = 8 * HTB, NXCD = 8, WGM = 8;

__host__ __device__ __forceinline__ int lds_byte(int r, int c) { const int st = (r >> 4) * 2 + (c >> 5), rr = r & 15, cc = c & 31, ob = rr * 64 + cc * 2; return st * 1024 + (ob ^ (((ob >> 9) & 1) << 5)); }
__host__ __device__ __forceinline__ void stage_rc(int b, int& R, int& C) { const int st = b / 1024, sb = b % 1024, swz = sb ^ (((sb >> 9) & 1) << 5); R = (st >> 1) * 16 + swz / 64; C = (st & 1) * 32 + (swz % 64) / 2; }
__host__ __device__ __forceinline__ int perm32(int rho) { const int n = rho >> 4, i = rho & 15; return 8 * (i >> 2) + 4 * n + (i & 3); }

struct Unit { int pm, pn; };
struct Gemm { const bf16_t* A; const bf16_t* Bt; int M, N, K, lda, ldb; };

struct StaticOrder {
    int nM, nN, nwg, G, c;
    __host__ __device__ void init(int M, int N, int G_, int c_) { nM = M / BM; nN = N / BM; nwg = nM * nN; G = G_; c = c_; }
    __host__ __device__ bool next(int i, Unit& u) const {
        const long L = (long)i * G + c; if (L >= nwg) return false;
        int wgid = (int)L; { const int q = nwg / NXCD, r = nwg % NXCD, xcd = wgid % NXCD, off = wgid / NXCD; wgid = (xcd < r ? xcd * (q + 1) : r * (q + 1) + (xcd - r) * q) + off; }
        const int nig = WGM * nN, gid = wgid / nig, fm = gid * WGM, gsz = (nM - fm) < WGM ? (nM - fm) : WGM;
        u.pm = fm + ((wgid % nig) % gsz); u.pn = (wgid % nig) / gsz; return true;
    }
    __device__ __forceinline__ void a_ready(const Unit&) const {}
    __device__ __forceinline__ void done(const Unit&) const {}
};
template <class Epi, class Sched, bool STAMP = false>
__device__ __forceinline__ void gemm_phase(PG8_LAS unsigned char* lds, const Gemm g, const Sched& S, const Epi& E, unsigned long long* stamps) {
    const int tid = tid_(), wid = __builtin_amdgcn_readfirstlane(tid >> 6), lane = tid & 63, wr = wid >> 2, wc = wid & 3, fr = lane & 15, fq = lane >> 4;
    const int K = g.K, nt = K / BK;

#define PG8_STAMP() do {} while (0)
    PG8_STAMP();
    unsigned voffA[2], voffB[2];
#pragma unroll
    for (int i = 0; i < 2; ++i) { int R, C; stage_rc(tid * 16 + i * 8192, R, C); const int Rb = Epi::PERM ? ((R & ~31) + perm32(R & 31)) : R;
        voffA[i] = (unsigned)(R * g.lda + C) * 2u; voffB[i] = (unsigned)(Rb * g.ldb + C) * 2u; }
    const size_t kstep = (size_t)(BK * 2);
    const size_t hstepA = (size_t)HALF * g.lda * 2, hstepB = (size_t)HALF * g.ldb * 2;
    const size_t tstepA = 2 * hstepA, tstepB = 2 * hstepB;
    const unsigned ldsw = (unsigned)wid * 1024u;
    const int aoff = lds_byte(wr * 64 + fr, fq * 8), boff = lds_byte(wc * 32 + fr, fq * 8);
#define PG8_SA(b, h) (((b) * 2 + (h)) * HTB)
#define PG8_SB(b, h) ((4 + (b) * 2 + (h)) * HTB)
#define PG8_STAGE(bufoff, gbase, voff) do { _Pragma("unroll") for (int _i = 0; _i < 2; ++_i) \
        __builtin_amdgcn_global_load_lds((const unsigned*)((const char*)(gbase) + (voff)[_i]), (PG8_LAS unsigned*)(lds + (bufoff) + ldsw + _i * 8192), 16, 0, 0); } while (0)
#define PG8_LDA(dst, b, h) do { _Pragma("unroll") for (int m = 0; m < 4; ++m) _Pragma("unroll") for (int k = 0; k < 2; ++k) dst[m][k] = *(const PG8_LAS bf16x8*)(lds + PG8_SA(b, h) + aoff + m * 2048 + k * 1024); } while (0)
#define PG8_LDB(dst, b, h) do { _Pragma("unroll") for (int n = 0; n < 2; ++n) _Pragma("unroll") for (int k = 0; k < 2; ++k) dst[n][k] = *(const PG8_LAS bf16x8*)(lds + PG8_SB(b, h) + boff + n * 2048 + k * 1024); } while (0)
#define PG8_MMA(ai, bj, At, Bt) do { __builtin_amdgcn_s_setprio(1); _Pragma("unroll") for (int m = 0; m < 4; ++m) _Pragma("unroll") for (int n = 0; n < 2; ++n) _Pragma("unroll") for (int k = 0; k < 2; ++k) \
        acc[ai][bj][m][n] = __builtin_amdgcn_mfma_f32_16x16x32_bf16(Bt[n][k], At[m][k], acc[ai][bj][m][n], 0, 0, 0); __builtin_amdgcn_s_setprio(0); } while (0)
#define PG8_WAIT_V(n) asm volatile("s_waitcnt vmcnt(" #n ")" ::: "memory")
#define PG8_WAIT_L(n) asm volatile("s_waitcnt lgkmcnt(" #n ")" ::: "memory")
#define PG8_BAR __builtin_amdgcn_s_barrier()
#define PG8_SCHED __builtin_amdgcn_sched_barrier(0)
    Unit cur, nxt; int ui = 0;
    if (!S.next(0, cur)) return;
    f32x4 acc[2][2][4][2];
#pragma unroll
    for (int a = 0; a < 2; ++a)
#pragma unroll
        for (int b = 0; b < 2; ++b)
#pragma unroll
            for (int m = 0; m < 4; ++m)
#pragma unroll
                for (int n = 0; n < 2; ++n) acc[a][b][m][n] = (f32x4){0.f, 0.f, 0.f, 0.f};
    bf16x8 At[4][2], B0[2][2], B1[2][2];
    const char* cA = (const char*)g.A + (size_t)cur.pm * tstepA; const char* cB = (const char*)g.Bt + (size_t)cur.pn * tstepB;
    S.a_ready(cur);
    PG8_STAGE(PG8_SB(0, 0), cB, voffB); PG8_STAGE(PG8_SA(0, 0), cA, voffA); PG8_STAGE(PG8_SB(0, 1), cB + hstepB, voffB); PG8_STAGE(PG8_SA(0, 1), cA + hstepA, voffA);
    if (wr == 1) PG8_BAR;
    PG8_WAIT_V(4); PG8_BAR;
    PG8_STAGE(PG8_SB(1, 0), cB + kstep, voffB); PG8_STAGE(PG8_SA(1, 0), cA + kstep, voffA); PG8_STAGE(PG8_SB(1, 1), cB + hstepB + kstep, voffB);
    PG8_WAIT_V(6); PG8_BAR;
    PG8_STAMP();
    for (;;) {
        const bool has_next = S.next(ui + 1, nxt);
        const char* nA = has_next ? (const char*)g.A + (size_t)nxt.pm * tstepA : cA; const char* nB = has_next ? (const char*)g.Bt + (size_t)nxt.pn * tstepB : cB;
#pragma unroll 1
        for (int t = 0; t < nt; t += 2) {
            const bool last = (t == nt - 2);
            const char* a1 = cA + (size_t)(t + 1) * kstep;
            const char* a2 = last ? nA : cA + (size_t)(t + 2) * kstep; const char* b2 = last ? nB : cB + (size_t)(t + 2) * kstep;
            const char* a3 = a2 + kstep; const char* b3 = b2 + kstep;
            if (last && has_next) S.a_ready(nxt);
            PG8_LDB(B0, 0, 0); PG8_SCHED; PG8_LDA(At, 0, 0); PG8_STAGE(PG8_SA(1, 1), a1 + hstepA, voffA);
            PG8_WAIT_L(8); PG8_BAR; PG8_WAIT_L(0); PG8_MMA(0, 0, At, B0); PG8_BAR; PG8_SCHED;
            PG8_LDB(B1, 0, 1); PG8_STAGE(PG8_SB(0, 0), b2, voffB);
            PG8_BAR; PG8_WAIT_L(0); PG8_MMA(0, 1, At, B1); PG8_BAR;
            PG8_LDA(At, 0, 1); PG8_STAGE(PG8_SA(0, 0), a2, voffA);
            PG8_BAR; PG8_WAIT_L(0); PG8_MMA(1, 0, At, B0); PG8_BAR; PG8_SCHED;
            PG8_STAGE(PG8_SB(0, 1), b2 + hstepB, voffB);
            PG8_WAIT_V(6); PG8_BAR; PG8_MMA(1, 1, At, B1); PG8_BAR;
            PG8_LDB(B0, 1, 0); PG8_SCHED; PG8_LDA(At, 1, 0); PG8_STAGE(PG8_SA(0, 1), a2 + hstepA, voffA);
            PG8_WAIT_L(8); PG8_BAR; PG8_WAIT_L(0); PG8_MMA(0, 0, At, B0); PG8_BAR; PG8_SCHED;
            PG8_LDB(B1, 1, 1); PG8_STAGE(PG8_SB(1, 0), b3, voffB);
            PG8_BAR; PG8_WAIT_L(0); PG8_MMA(0, 1, At, B1); PG8_BAR;
            PG8_LDA(At, 1, 1); PG8_STAGE(PG8_SA(1, 0), a3, voffA);
            PG8_BAR; PG8_WAIT_L(0); PG8_MMA(1, 0, At, B0); PG8_BAR; PG8_SCHED;
            PG8_STAGE(PG8_SB(1, 1), b3 + hstepB, voffB);
            PG8_WAIT_V(6); PG8_BAR; PG8_MMA(1, 1, At, B1); PG8_BAR;
        }
        PG8_STAMP();
        if constexpr (!Epi::AFTER_DRAIN) { E(acc, cur, wr, wc, fr, fq); S.done(cur); }
        PG8_STAMP();
        if (!has_next) break;
#pragma unroll
        for (int a = 0; a < 2; ++a)
#pragma unroll
            for (int b = 0; b < 2; ++b)
#pragma unroll
                for (int m = 0; m < 4; ++m)
#pragma unroll
                    for (int n = 0; n < 2; ++n) acc[a][b][m][n] = (f32x4){0.f, 0.f, 0.f, 0.f};
        cur = nxt; cA = nA; cB = nB; ++ui;
    }
    PG8_WAIT_V(0);
    if (wr == 0) PG8_BAR;
    PG8_BAR;
    if constexpr (Epi::AFTER_DRAIN) { E.fused(acc, cur, wr, wc, fr, fq, lds, wid, lane); S.done(cur); }
    PG8_STAMP();
#undef PG8_STAMP
#undef PG8_SA
#undef PG8_SB
#undef PG8_STAGE
#undef PG8_LDA
#undef PG8_LDB
#undef PG8_MMA
#undef PG8_WAIT_V
#undef PG8_WAIT_L
#undef PG8_BAR
#undef PG8_SCHED
}
}

#include <cstdio>
#include <ctime>
#include <cstdlib>
#include <cstring>

__device__ void transpose_w(const float* src, int K, int N, u16* dst, int ldb, int koff, int mode, char* smem) {
  float* t = (float*)smem;
  const int tk = K >> 6, tn = N >> 6;
  const int tid = tid_();
  for (int tile = bid_(); tile < tk * tn; tile += gridDim.x) {
    const int k0 = (tile / tn) * 64, n0 = (tile % tn) * 64;
    __syncthreads();
#pragma unroll
    for (int p = 0; p < 2; p++) {
      int i = (tid >> 4) + 32 * p, j4 = (tid & 15) * 4;
      float4 v = *(const float4*)(src + (size_t)(k0 + i) * N + n0 + j4);
      t[i * 65 + j4] = v.x; t[i * 65 + j4 + 1] = v.y; t[i * 65 + j4 + 2] = v.z; t[i * 65 + j4 + 3] = v.w;
    }
    __syncthreads();
    {
      int n = (tid >> 3), ks = (tid & 7) * 8;
      u32x4 w;
#pragma unroll
      for (int q = 0; q < 4; q++) {
        u16 lo = f2bf(t[(ks + 2 * q) * 65 + n]);
        u16 hi = f2bf(t[(ks + 2 * q + 1) * 65 + n]);
        w[q] = (unsigned)lo | ((unsigned)hi << 16);
      }
      int gn = n0 + n;
      int row = gn;
      if (mode == 1) row = (gn >> 7) * 256 + (gn & 127);
      else if (mode == 2) row = (gn >> 7) * 256 + 128 + (gn & 127);
      *(u32x4*)(dst + (size_t)row * ldb + koff + k0 + ks) = w;
    }
  }
}

__device__ void phase_prep0(const Params& P, char* smem) {
  const size_t gtid = (size_t)bid_() * NTHREADS + tid_();
  const size_t gsz = (size_t)gridDim.x * NTHREADS;
  {
    const float4* xp = (const float4*)P.in[0];
    const float4* xs = (const float4*)P.in[1];
    float4* xf = (float4*)((float*)(P.ws + OFF_XF));
    const size_t np = (size_t)MP * DM / 4, ns = (size_t)MS * DM / 4;
    for (size_t i = gtid; i < np + ns; i += gsz) xf[i] = (i < np) ? xp[i] : xs[i - np];
  }
  {
    const size_t per = (size_t)MT * 256 / 4;
    for (size_t i = gtid; i < 4 * per; i += gsz) {
      int l = (int)(i / per);
      size_t r = i % per;
      size_t e = r * 4;
      float4 v;
      if (e < (size_t)MP * 256) v = *(const float4*)(P.in[8] + (size_t)l * MP * 256 + e);
      else v = *(const float4*)(P.in[9] + (size_t)l * MS * 256 + (e - (size_t)MP * 256));
      uint2 o;
      o.x = (unsigned)f2bf(v.x) | ((unsigned)f2bf(v.y) << 16);
      o.y = (unsigned)f2bf(v.z) | ((unsigned)f2bf(v.w) << 16);
      *(uint2*)(((u16*)(P.ws + OFF_PB)) + (size_t)l * MT * 256 + e) = o;
    }
  }
  {
    for (int g = 0; g < 3; g++) {
      const int W = (g == 0) ? 128 : (g == 1 ? 512 : 2048);
      const size_t ofs = (g == 0) ? O_KV128S : (g == 1 ? O_KV512S : O_KV2048S);
      const float4* src = (const float4*)P.in[5 + g];
      float4* dst = (float4*)(P.out + ofs);
      const size_t rowsPer = (size_t)(W - 8) * 64;
      const size_t total = 128 * rowsPer;
      for (size_t i = gtid; i < total; i += gsz) {
        size_t ln = i / rowsPer, r = i % rowsPer;
        dst[ln * (size_t)W * 64 + r] = src[ln * (size_t)W * 64 + 8 * 64 + r];
      }
    }
  }
  {
    for (size_t i = gtid; i < 8200 * 32; i += gsz) {
      int pos = (int)(i >> 5), fi = (int)(i & 31);
      float inv = powf(10000.0f, -2.0f * (float)fi / 64.0f);
      float ang = (float)pos * inv;
      double rev = (double)ang * 0.15915494309189533577;
      rev -= rint(rev);
      float rf = (float)rev;
      ((float*)(P.ws + OFF_ROPE))[i * 2] = __builtin_amdgcn_cosf(rf);
      ((float*)(P.ws + OFF_ROPE))[i * 2 + 1] = __builtin_amdgcn_sinf(rf);
    }
  }
  for (size_t i = gtid; i < (size_t)MT * 128; i += gsz) {
    size_t m = i >> 7, c = i & 127;
    ((u16*)(P.ws + OFF_DP))[m * DPW + 384 + c] = 0;
  }
  for (int l = 0; l < 4; l++) {
    u16* wl = ((u16*)(P.ws + OFF_W_LORA)) + (size_t)l * LOW * 256;
    const float* w2 = P.in[16] + (size_t)l * 64 * 384;
    const float* a2 = P.in[18] + (size_t)l * 64 * 384;
    const float* g2 = P.in[19] + (size_t)l * 128 * 384;
    for (size_t i = gtid; i < LOW * 256; i += gsz) {
      int k = (int)(i / LOW), n = (int)(i % LOW);
      float v = 0.f;
      if (n < 384) { if (k < 64) v = w2[k * 384 + n]; }
      else if (n < 768) { if (k >= 64 && k < 128) v = a2[(k - 64) * 384 + (n - 384)]; }
      else if (n < 1152) { if (k >= 128) v = g2[(k - 128) * 384 + (n - 768)]; }
      wl[(size_t)n * 256 + k] = f2bf(v);
    }
    u16* wm = ((u16*)(P.ws + OFF_W_MERGE)) + (size_t)l * 1024 * DPW;
    const float* wg = P.in[12] + (size_t)l * 4 * 64 * 64;
    const float* sc = P.in[13] + (size_t)l * 256;
    const float* pp = P.in[25] + (size_t)l * 256 * 1024;
    for (size_t i = gtid; i < 256 * 1024; i += gsz) {
      int k = (int)(i >> 10), n = (int)(i & 1023);
      int g = k >> 6, c = k & 63;
      float s = 0.f;
      for (int j = 0; j < 64; j++) s += wg[(g * 64 + c) * 64 + j] * sc[g * 64 + j] * pp[(size_t)(g * 64 + j) * 1024 + n];
      wm[(size_t)n * DPW + k] = f2bf(s);
    }
    for (size_t i = gtid; i < 128 * 1024; i += gsz) {
      int k = (int)(i & 127), n = (int)(i >> 7);
      wm[(size_t)n * DPW + 384 + k] = 0;
    }
  }
  for (int l = 0; l < 4; l++) {
    transpose_w(P.in[11] + (size_t)l * 1024 * 5888, 1024, 5888, ((u16*)(P.ws + OFF_W_IN)) + (size_t)l * 5888 * 1024, 1024, 0, 0, smem);
    transpose_w(P.in[26] + (size_t)l * 128 * 1024, 128, 1024, ((u16*)(P.ws + OFF_W_MERGE)) + (size_t)l * 1024 * DPW, DPW, 256, 0, smem);
    transpose_w(P.in[27] + (size_t)l * 384 * 1024, 384, 1024, ((u16*)(P.ws + OFF_W_MERGE)) + (size_t)l * 1024 * DPW, DPW, 512, 0, smem);
    transpose_w(P.in[28] + (size_t)l * 1024 * 1024, 1024, 1024, ((u16*)(P.ws + OFF_W_OUT)) + (size_t)l * 1024 * 1024, 1024, 0, 0, smem);
    transpose_w(P.in[30] + (size_t)l * 1024 * 2816, 1024, 2816, ((u16*)(P.ws + OFF_W_13)) + (size_t)l * 5632 * 1024, 1024, 0, 1, smem);
    transpose_w(P.in[31] + (size_t)l * 1024 * 2816, 1024, 2816, ((u16*)(P.ws + OFF_W_13)) + (size_t)l * 5632 * 1024, 1024, 0, 2, smem);
    transpose_w(P.in[32] + (size_t)l * 2816 * 1024, 2816, 1024, ((u16*)(P.ws + OFF_W_2)) + (size_t)l * 1024 * 2816, 2816, 0, 0, smem);
    transpose_w(P.in[35] + (size_t)l * 1024 * 1024, 1024, 1024, ((u16*)(P.ws + OFF_W_PG)) + (size_t)l * 1024 * 1024, 1024, 0, 0, smem);
    transpose_w(P.in[34] + (size_t)l * 256 * 1024, 256, 1024, ((u16*)(P.ws + OFF_W_PP)) + (size_t)l * 1024 * 256, 256, 0, 0, smem);
  }
}

__device__ void phase_rmsnorm(const Params& P, const float* g, bool final_) {
  const int lane = tid_() & 63;
  const int gw = (bid_() * NTHREADS + tid_()) >> 6;
  const int nw = gridDim.x * (NTHREADS / 64);
  for (int m = gw; m < MT; m += nw) {
    const float4* x = (const float4*)(((float*)(P.ws + OFF_XF)) + (size_t)m * DM);
    float4 v[4];
    float ss = 0.f;
#pragma unroll
    for (int p = 0; p < 4; p++) {
      v[p] = x[p * 64 + lane];
      ss += v[p].x * v[p].x + v[p].y * v[p].y + v[p].z * v[p].z + v[p].w * v[p].w;
    }
    ss = wave_sum(ss);
    float rstd = rsqrtf(ss * (1.f / DM) + 1e-6f);
#pragma unroll
    for (int p = 0; p < 4; p++) {
      float4 gg = ((const float4*)g)[p * 64 + lane];
      float a = v[p].x * rstd * gg.x, b = v[p].y * rstd * gg.y, c = v[p].z * rstd * gg.z, d = v[p].w * rstd * gg.w;
      if (final_) {
        float* o = (m < MP) ? (P.out + O_YP + (size_t)m * DM) : (P.out + O_YS + (size_t)(m - MP) * DM);
        ((float4*)o)[p * 64 + lane] = make_float4(a, b, c, d);
      } else {
        uint2 o;
        o.x = (unsigned)f2bf(a) | ((unsigned)f2bf(b) << 16);
        o.y = (unsigned)f2bf(c) | ((unsigned)f2bf(d) << 16);
        ((uint2*)(((u16*)(P.ws + OFF_H)) + (size_t)m * DM))[p * 64 + lane] = o;
      }
    }
  }
}

typedef f32x4 acc_t[2][2][4][2];
__device__ __forceinline__ u32x4 pack8(f32x4 a, f32x4 b) {
  u32x4 r;
  r[0] = (unsigned)f2bf(a[0]) | ((unsigned)f2bf(a[1]) << 16);
  r[1] = (unsigned)f2bf(a[2]) | ((unsigned)f2bf(a[3]) << 16);
  r[2] = (unsigned)f2bf(b[0]) | ((unsigned)f2bf(b[1]) << 16);
  r[3] = (unsigned)f2bf(b[2]) | ((unsigned)f2bf(b[3]) << 16);
  return r;
}
__device__ __forceinline__ void unpack8(u32x4 g, f32x4& a, f32x4& b) {
  a[0] = __uint_as_float(g[0] << 16); a[1] = __uint_as_float(g[0] & 0xffff0000u);
  a[2] = __uint_as_float(g[1] << 16); a[3] = __uint_as_float(g[1] & 0xffff0000u);
  b[0] = __uint_as_float(g[2] << 16); b[1] = __uint_as_float(g[2] & 0xffff0000u);
  b[2] = __uint_as_float(g[3] << 16); b[3] = __uint_as_float(g[3] & 0xffff0000u);
}
__device__ __forceinline__ f32x4 sig4(f32x4 v) { f32x4 r; r[0] = sigmoidf_(v[0]); r[1] = sigmoidf_(v[1]); r[2] = sigmoidf_(v[2]); r[3] = sigmoidf_(v[3]); return r; }

#define EPI_LOOP(...)                                                                   \
  {                                                                                     \
    int _fr = fr, _fq = fq;                                                             \
    asm volatile("" : "+v"(_fr), "+v"(_fq));                                            \
    const int row0 = u.pm * 256 + wr * 64 + _fr, col0 = u.pn * 256 + wc * 32 + _fq * 8; \
    _Pragma("unroll") for (int ai = 0; ai < 2; ++ai)                                    \
    _Pragma("unroll") for (int m = 0; m < 4; ++m) {                                     \
      asm volatile("" ::: "memory");                                                    \
      __builtin_amdgcn_sched_barrier(0);                                                \
      const int row = row0 + ai * 128 + m * 16;                                         \
      _Pragma("unroll") for (int bj = 0; bj < 2; ++bj) {                                \
        const int col = col0 + bj * 128;                                                \
        const f32x4 v0 = acc[ai][bj][m][0], v1 = acc[ai][bj][m][1];                     \
        __VA_ARGS__                                                                     \
      }                                                                                 \
    }                                                                                   \
  }

struct EpiIn {
  static constexpr bool PERM = true, AFTER_DRAIN = false;
  float* Z; u16* G;
  __device__ __forceinline__ void operator()(const acc_t& acc, const pg8::Unit& u, int wr, int wc, int fr, int fq) const {
    if (u.pn < 11) {
      EPI_LOOP({ float* p = Z + (size_t)row * ZW + col; *(f32x4*)p = v0; *(f32x4*)(p + 4) = v1; })
    } else {
      EPI_LOOP({ *(u32x4*)(G + (size_t)row * GW + (col - ZW)) = pack8(sig4(v0), sig4(v1)); })
    }
  }
};
struct EpiLora {
  static constexpr bool PERM = true, AFTER_DRAIN = false;
  float* LO;
  __device__ __forceinline__ void operator()(const acc_t& acc, const pg8::Unit& u, int wr, int wc, int fr, int fq) const {
    EPI_LOOP({ float* p = LO + (size_t)row * LOW + col; *(f32x4*)p = v0; *(f32x4*)(p + 4) = v1; })
  }
};
template <int STAGE>
struct EpiMerge {
  static constexpr bool PERM = true, AFTER_DRAIN = false;
  const u16* Gt; float* T; u16* MG;
  __device__ __forceinline__ void operator()(const acc_t& acc, const pg8::Unit& u, int wr, int wc, int fr, int fq) const {
    EPI_LOOP({
      f32x4 g0, g1;
      unpack8(*(const u32x4*)(Gt + (size_t)row * GW + col), g0, g1);
      float* p = T + (size_t)row * DM + col;
      f32x4 a = g0 * v0, b = g1 * v1;
      if (STAGE == 0) { *(f32x4*)p = a; *(f32x4*)(p + 4) = b; }
      else if (STAGE == 1) { *(f32x4*)p = *(f32x4*)p + a; *(f32x4*)(p + 4) = *(f32x4*)(p + 4) + b; }
      else { *(u32x4*)(MG + (size_t)row * DM + col) = pack8(*(f32x4*)p + a, *(f32x4*)(p + 4) + b); }
    })
  }
};
struct EpiResid {
  static constexpr bool PERM = true, AFTER_DRAIN = false;
  float* XF;
  __device__ __forceinline__ void operator()(const acc_t& acc, const pg8::Unit& u, int wr, int wc, int fr, int fq) const {
    EPI_LOOP({ float* p = XF + (size_t)row * DM + col; *(f32x4*)p = *(f32x4*)p + v0; *(f32x4*)(p + 4) = *(f32x4*)(p + 4) + v1; })
  }
};
struct Epi13 {
  static constexpr bool PERM = true, AFTER_DRAIN = false;
  u16* HID;
  __device__ __forceinline__ void operator()(const acc_t& acc, const pg8::Unit& u, int wr, int wc, int fr, int fq) const {
    int _fr = fr, _fq = fq;
    asm volatile("" : "+v"(_fr), "+v"(_fq));
    const int row0 = u.pm * 256 + wr * 64 + _fr, col0 = u.pn * 128 + wc * 32 + _fq * 8;
#pragma unroll
    for (int ai = 0; ai < 2; ++ai)
#pragma unroll
      for (int m = 0; m < 4; ++m) {
        const int row = row0 + ai * 128 + m * 16;
        f32x4 h0, h1;
#pragma unroll
        for (int j = 0; j < 4; j++) {
          float a = acc[ai][0][m][0][j], b = acc[ai][1][m][0][j];
          h0[j] = a * sigmoidf_(a) * b;
          float c = acc[ai][0][m][1][j], d = acc[ai][1][m][1][j];
          h1[j] = c * sigmoidf_(c) * d;
        }
        *(u32x4*)(HID + (size_t)row * 2816 + col0) = pack8(h0, h1);
      }
  }
};
struct EpiPG {
  static constexpr bool PERM = true, AFTER_DRAIN = false;
  u16* PG;
  __device__ __forceinline__ void operator()(const acc_t& acc, const pg8::Unit& u, int wr, int wc, int fr, int fq) const {
    EPI_LOOP({ *(u32x4*)(PG + (size_t)row * DM + col) = pack8(sig4(v0), sig4(v1)); })
  }
};
struct EpiPP {
  static constexpr bool PERM = true, AFTER_DRAIN = false;
  const u16* PG; float* XF;
  __device__ __forceinline__ void operator()(const acc_t& acc, const pg8::Unit& u, int wr, int wc, int fr, int fq) const {
    EPI_LOOP({
      f32x4 g0, g1;
      unpack8(*(const u32x4*)(PG + (size_t)row * DM + col), g0, g1);
      float* p = XF + (size_t)row * DM + col;
      *(f32x4*)p = *(f32x4*)p + g0 * v0; *(f32x4*)(p + 4) = *(f32x4*)(p + 4) + g1 * v1;
    })
  }
};

template <class Epi>
__device__ __forceinline__ void run_gemm(char* smem, const u16* A, int lda, const u16* Bt, int ldb, int N, int K, const Epi& E) {
  pg8::Gemm g; g.A = A; g.Bt = Bt; g.M = MT; g.N = N; g.K = K; g.lda = lda; g.ldb = ldb;
  pg8::StaticOrder S; S.init(MT, N, gridDim.x, bid_());
  pg8::gemm_phase<Epi, pg8::StaticOrder, false>((PG8_LAS unsigned char*)smem, g, S, E, nullptr);
}

__device__ __forceinline__ float zs_val(const Params& P, int l, int m, int rc) {
  float zc = ((float*)(P.ws + OFF_Z))[(size_t)m * ZW + 1408 + rc];
  float prev;
  if (m < MP) {
    int t = m & 8191;
    prev = t ? ((float*)(P.ws + OFF_Z))[(size_t)(m - 1) * ZW + 1408 + rc] : 0.f;
  } else {
    int ms = m - MP;
    int t = ms & 7;
    prev = t ? ((float*)(P.ws + OFF_Z))[(size_t)(m - 1) * ZW + 1408 + rc] : P.in[3][(size_t)(l * 32 + (ms >> 3)) * 1408 + rc];
  }
  return zc + (prev - zc) * P.in[14][l * 1408 + rc];
}

__device__ void phase_prep(const Params& P, int l) {
  const size_t gtid = (size_t)bid_() * NTHREADS + tid_();
  const size_t gsz = (size_t)gridDim.x * NTHREADS;
  for (size_t i = gtid; i < (size_t)MT * 256; i += gsz) {
    int m = (int)(i >> 8), c = (int)(i & 255);
    int w = 2 << (c >> 6);
    float u = ((float*)(P.ws + OFF_Z))[(size_t)m * ZW + c];
    float s = 0.f, cnt;
    if (m < MP) {
      int t = m & 8191;
      int n = (t + 1 < w) ? t + 1 : w;
      for (int j = 0; j < n; j++) s += ((float*)(P.ws + OFF_Z))[(size_t)(m - j) * ZW + c];
      cnt = (float)n;
    } else {
      int ms = m - MP, t = ms & 7, ns = ms >> 3;
      for (int j = 0; j < w; j++) {
        int idx = 15 + t - j;
        s += (idx >= 15) ? ((float*)(P.ws + OFF_Z))[(size_t)(m - j) * ZW + c] : P.in[2][((size_t)(l * 32 + ns) * 15 + idx) * 256 + c];
      }
      cnt = (float)w;
    }
    ((u16*)(P.ws + OFF_DP))[(size_t)m * DPW + c] = f2bf(s / cnt - u);
  }
  for (size_t i = gtid; i < 2 * 15 * 256; i += gsz) {
    int c = (int)(i & 255), r = (int)(i >> 8), n = r / 15, ii = r % 15;
    P.out[O_POOLP + ((size_t)(l * 2 + n) * 15 + ii) * 256 + c] = ((float*)(P.ws + OFF_Z))[(size_t)(n * 8192 + 8177 + ii) * ZW + c];
  }
  for (size_t i = gtid; i < 32 * 15 * 256; i += gsz) {
    int c = (int)(i & 255), r = (int)(i >> 8), n = r / 15, ii = r % 15;
    float v = (ii < 7) ? P.in[2][((size_t)(l * 32 + n) * 15 + 8 + ii) * 256 + c]
                       : ((float*)(P.ws + OFF_Z))[(size_t)(MP + n * 8 + (ii - 7)) * ZW + c];
    P.out[O_POOLS + ((size_t)(l * 32 + n) * 15 + ii) * 256 + c] = v;
  }
  for (size_t i = gtid; i < (size_t)MT * 192; i += gsz) {
    int m = (int)(i / 192), rr = (int)(i % 192), head = rr >> 5, fi = rr & 31;
    int gi = head >> 1, hh = head & 1;
    int W = (gi == 0) ? 128 : (gi == 1 ? 512 : 2048);
    int dil = (gi == 0) ? 1 : (gi == 1 ? 4 : 16);
    size_t offp = (gi == 0) ? O_KV128P : (gi == 1 ? O_KV512P : O_KV2048P);
    size_t offs = (gi == 0) ? O_KV128S : (gi == 1 ? O_KV512S : O_KV2048S);
    const float* z = ((float*)(P.ws + OFF_Z)) + (size_t)m * ZW;
    int pos, n, t;
    if (m < MP) { n = m >> 13; t = m & 8191; pos = t; }
    else { int ms = m - MP; n = ms >> 3; t = ms & 7; pos = 8192 + t; }
    float cs = ((float*)(P.ws + OFF_ROPE))[((size_t)pos * 32 + fi) * 2], sn = ((float*)(P.ws + OFF_ROPE))[((size_t)pos * 32 + fi) * 2 + 1];
    float q1 = z[256 + head * 64 + fi], q2 = z[256 + head * 64 + fi + 32];
    float k1 = z[640 + head * 64 + fi], k2 = z[640 + head * 64 + fi + 32];
    float v1 = z[1024 + head * 64 + fi], v2 = z[1024 + head * 64 + fi + 32];
    float qa = (q1 * cs - q2 * sn) * 0.125f, qb = (q2 * cs + q1 * sn) * 0.125f;
    float ka = k1 * cs - k2 * sn, kb = k2 * cs + k1 * sn;
    if (m < MP) {
      int L = 8192 / dil;
      int sidx = (t % dil) * L + t / dil;
      size_t base = ((size_t)(n * 6 + head) * 8192 + sidx) * 64;
      ((u16*)(P.ws + OFF_QS_))[base + fi] = f2bf(qa); ((u16*)(P.ws + OFF_QS_))[base + fi + 32] = f2bf(qb);
      ((u16*)(P.ws + OFF_KS_))[base + fi] = f2bf(ka); ((u16*)(P.ws + OFF_KS_))[base + fi + 32] = f2bf(kb);
      if (t >= 8192 - W) {
        float* o = P.out + offp + ((size_t)(l * 2 + n) * W + (t - (8192 - W))) * 256;
        o[hh * 64 + fi] = ka; o[hh * 64 + fi + 32] = kb;
        o[128 + hh * 64 + fi] = v1; o[128 + hh * 64 + fi + 32] = v2;
      }
    } else {
      int ms = m - MP;
      float* qs = ((float*)(P.ws + OFF_QSAMP)) + ((size_t)ms * 6 + head) * 64;
      qs[fi] = qa; qs[fi + 32] = qb;
      float* o = P.out + offs + ((size_t)(l * 32 + n) * W + (W - 8 + t)) * 256;
      o[hh * 64 + fi] = ka; o[hh * 64 + fi + 32] = kb;
      o[128 + hh * 64 + fi] = v1; o[128 + hh * 64 + fi + 32] = v2;
    }
  }
  for (size_t i = gtid; i < (size_t)12 * 1024 * 64; i += gsz) {
    int dd = (int)(i & 63);
    int ch = (int)((i >> 6) & 1023);
    int nh = (int)(i >> 16);
    int n = nh / 6, head = nh % 6, gi = head >> 1;
    int dil = (gi == 0) ? 1 : (gi == 1 ? 4 : 16);
    int L = 8192 / dil;
    int s0 = ch * 8;
    int r = s0 / L, l0 = s0 % L;
    unsigned w[4];
#pragma unroll
    for (int q = 0; q < 4; q++) {
      int t0 = (l0 + 2 * q) * dil + r, t1 = (l0 + 2 * q + 1) * dil + r;
      u16 a = f2bf(((float*)(P.ws + OFF_Z))[(size_t)(n * 8192 + t0) * ZW + 1024 + head * 64 + dd]);
      u16 b = f2bf(((float*)(P.ws + OFF_Z))[(size_t)(n * 8192 + t1) * ZW + 1024 + head * 64 + dd]);
      w[q] = (unsigned)a | ((unsigned)b << 16);
    }
    *(uint4*)(((u16*)(P.ws + OFF_VT)) + ((size_t)nh * 64 + dd) * 8192 + s0) = make_uint4(w[0], w[1], w[2], w[3]);
  }
  for (size_t i = gtid; i < (size_t)MT * 256; i += gsz) {
    int m = (int)(i >> 8), j = (int)(i & 255);
    float zs = zs_val(P, l, m, 1152 + j);
    float v = (j < 64) ? tanhf(zs) : (j < 128 ? zs : sigmoidf_(zs));
    ((u16*)(P.ws + OFF_AL))[i] = f2bf(v);
  }
  for (size_t i = gtid; i < 2 * 1408; i += gsz) {
    int n = (int)(i / 1408), c = (int)(i % 1408);
    P.out[O_SHIFTP + (size_t)(l * 2 + n) * 1408 + c] = ((float*)(P.ws + OFF_Z))[(size_t)(n * 8192 + 8191) * ZW + 1408 + c];
  }
  for (size_t i = gtid; i < 32 * 1408; i += gsz) {
    int n = (int)(i / 1408), c = (int)(i % 1408);
    P.out[O_SHIFTS + (size_t)(l * 32 + n) * 1408 + c] = ((float*)(P.ws + OFF_Z))[(size_t)(MP + n * 8 + 7) * ZW + 1408 + c];
  }
}

__device__ void phase_rwkv_prep(const Params& P, int l) {
  const int lane = tid_() & 63;
  const int gw = (bid_() * NTHREADS + tid_()) >> 6;
  const int nw = gridDim.x * (NTHREADS / 64);
  for (int task = gw; task < MT * 6; task += nw) {
    int m = task / 6, h = task % 6;
    int C = h * 64 + lane;
    float r = zs_val(P, l, m, C);
    float k = zs_val(P, l, m, 384 + C);
    float v = zs_val(P, l, m, 768 + C);
    const float* lo = ((float*)(P.ws + OFF_LO)) + (size_t)m * LOW;
    float x = P.in[15][l * 384 + C] + lo[C];
    float nx = -x;
    float sp = fmaxf(nx, 0.f) + log1pf(__expf(-fabsf(nx)));
    float wlog = -sp - 0.5f;
    float decay = __expf(-__expf(wlog));
    float a = sigmoidf_(P.in[17][l * 384 + C] + lo[384 + C]);
    float kk = k * P.in[20][l * 384 + C];
    float ss = wave_sum(kk * kk);
    kk *= rsqrtf(fmaxf(ss, 1e-24f));
    float k2 = k * (1.f + (a - 1.f) * P.in[21][l * 384 + C]);
    float bon = wave_sum(r * k2 * P.in[22][l * 384 + C]);
    float* sc = ((float*)(P.ws + OFF_SC)) + ((size_t)m * 6 + h) * 384;
    sc[lane] = r; sc[64 + lane] = decay; sc[128 + lane] = k2; sc[192 + lane] = kk; sc[256 + lane] = kk * a; sc[320 + lane] = v;
    if (lane == 0) ((float*)(P.ws + OFF_BON))[(size_t)m * 6 + h] = bon;
  }
}

__device__ __forceinline__ void rwkv_finalize(const Params& P, int l, int m, int h, int lane, float y) {
  int C = h * 64 + lane;
  float mu = wave_sum(y) * (1.f / 64.f);
  float d = y - mu;
  float var = wave_sum(d * d) * (1.f / 64.f);
  float yn = d * rsqrtf(var + 64e-5f) * P.in[23][l * 384 + C] + P.in[24][l * 384 + C];
  float bonus = ((float*)(P.ws + OFF_BON))[(size_t)m * 6 + h] * ((float*)(P.ws + OFF_SC))[((size_t)m * 6 + h) * 384 + 320 + lane];
  float g = ((float*)(P.ws + OFF_LO))[(size_t)m * LOW + 768 + C];
  ((u16*)(P.ws + OFF_DP))[(size_t)m * DPW + 512 + C] = f2bf((yn + bonus) * g);
}

#define CH 4
template <int KIND>
__device__ void scan_wave(const Params& P, int l, int wt, float* lds) {
  const int lane = tid_() & 63;
  int m0, h, nsteps, nh = 0, seg = 0, ns = 0;
  if (KIND == 2) { ns = wt / 6; h = wt % 6; m0 = MP + ns * 8; nsteps = 8; }
  else { int g = wt >> 1; seg = g & 31; nh = g >> 5; int n = nh / 6; h = nh % 6; m0 = n * 8192 + seg * SEGLEN; nsteps = SEGLEN; }
  float S[64];
  if (KIND == 0) {
#pragma unroll
    for (int k = 0; k < 64; k++) S[k] = 0.f;
  } else if (KIND == 1) {
#pragma unroll
    for (int k = 0; k < 64; k++) S[k] = (k == lane) ? 1.f : 0.f;
  } else {
    const float4* s0 = (const float4*)(P.in[4] + (((size_t)(l * 32 + ns) * 6 + h) * 64 + lane) * 64);
#pragma unroll
    for (int k = 0; k < 16; k++) { float4 v = s0[k]; S[4 * k] = v.x; S[4 * k + 1] = v.y; S[4 * k + 2] = v.z; S[4 * k + 3] = v.w; }
  }
  f32x4 stg[6];
  const int nch = nsteps / CH;
  {
    const float* src = ((float*)(P.ws + OFF_SC)) + ((size_t)m0 * 6 + h) * 384;
#pragma unroll
    for (int q = 0; q < 6; q++) {
      int e = q * 64 + lane; int st = e / 96, w = e % 96;
      stg[q] = *(const f32x4*)(src + (size_t)st * 2304 + w * 4);
    }
  }
  for (int c = 0; c < nch; c++) {
#pragma unroll
    for (int q = 0; q < 6; q++) ((f32x4*)lds)[q * 64 + lane] = stg[q];
    if (c + 1 < nch) {
      const float* src = ((float*)(P.ws + OFF_SC)) + ((size_t)(m0 + (c + 1) * CH) * 6 + h) * 384;
#pragma unroll
      for (int q = 0; q < 6; q++) {
        int e = q * 64 + lane; int st = e / 96, w = e % 96;
        stg[q] = *(const f32x4*)(src + (size_t)st * 2304 + w * 4);
      }
    }
#pragma unroll 1
    for (int s = 0; s < CH; s++) {
      const float4* o = (const float4*)(lds + s * 384);
      const int m = m0 + c * CH + s;
      float sa = 0.f;
#pragma unroll
      for (int k = 0; k < 16; k++) {
        float4 kk = o[48 + k];
        sa -= S[4 * k] * kk.x; sa -= S[4 * k + 1] * kk.y; sa -= S[4 * k + 2] * kk.z; sa -= S[4 * k + 3] * kk.w;
      }
      float vv = 0.f;
      if (KIND != 1) vv = lds[s * 384 + 320 + lane];
      float y = 0.f;
#pragma unroll
      for (int k = 0; k < 16; k++) {
        float4 w = o[16 + k], b = o[64 + k], r = o[k];
        if (KIND != 1) {
          float4 kv = o[32 + k];
          S[4 * k] = S[4 * k] * w.x + (sa * b.x + vv * kv.x);
          S[4 * k + 1] = S[4 * k + 1] * w.y + (sa * b.y + vv * kv.y);
          S[4 * k + 2] = S[4 * k + 2] * w.z + (sa * b.z + vv * kv.z);
          S[4 * k + 3] = S[4 * k + 3] * w.w + (sa * b.w + vv * kv.w);
        } else {
          S[4 * k] = S[4 * k] * w.x + sa * b.x;
          S[4 * k + 1] = S[4 * k + 1] * w.y + sa * b.y;
          S[4 * k + 2] = S[4 * k + 2] * w.z + sa * b.z;
          S[4 * k + 3] = S[4 * k + 3] * w.w + sa * b.w;
        }
        y += S[4 * k] * r.x; y += S[4 * k + 1] * r.y; y += S[4 * k + 2] * r.z; y += S[4 * k + 3] * r.w;
      }
      if (KIND == 0) ((float*)(P.ws + OFF_YL))[(size_t)m * 384 + h * 64 + lane] = y;
      else if (KIND == 1) ((float*)(P.ws + OFF_QT))[(size_t)m * 384 + h * 64 + lane] = y;
      else rwkv_finalize(P, l, m, h, lane, y);
    }
  }
  float* dst;
  if (KIND == 0) dst = ((float*)(P.ws + OFF_LEND)) + ((size_t)(nh * NSEG + seg) * 64 + lane) * 64;
  else if (KIND == 1) dst = ((float*)(P.ws + OFF_QEND)) + ((size_t)(nh * NSEG + seg) * 64 + lane) * 64;
  else dst = P.out + O_WKVS + (((size_t)(l * 32 + ns) * 6 + h) * 64 + lane) * 64;
#pragma unroll
  for (int k = 0; k < 16; k++) ((float4*)dst)[k] = make_float4(S[4 * k], S[4 * k + 1], S[4 * k + 2], S[4 * k + 3]);
}

__device__ void attn_prompt_wave(const Params& P, int task) {
  const int lane = tid_() & 63, c = lane & 31, hi = lane >> 5;
  const int qb = task & 255, nh = task >> 8;
  const int n = nh / 6, head = nh % 6, gi = head >> 1;
  const int dil = (gi == 0) ? 1 : (gi == 1 ? 4 : 16);
  const int L = 8192 / dil;
  const int sidx0 = qb * 32, r = sidx0 / L, l0 = sidx0 % L;
  const u16* Kb = ((u16*)(P.ws + OFF_KS_)) + (size_t)nh * 8192 * 64;
  const u16* Qb = ((u16*)(P.ws + OFF_QS_)) + (size_t)nh * 8192 * 64;
  const u16* Vb = ((u16*)(P.ws + OFF_VT)) + (size_t)nh * 64 * 8192;
  bf16x8 qf[4];
#pragma unroll
  for (int ch = 0; ch < 4; ch++) qf[ch] = *(const bf16x8*)(Qb + (size_t)(sidx0 + c) * 64 + ch * 16 + hi * 8);
  f32x16 o0, o1;
#pragma unroll
  for (int i = 0; i < 16; i++) { o0[i] = 0.f; o1[i] = 0.f; }
  float mrun = -INFINITY, lrun = 0.f;
  for (int kt = 0; kt < 5; kt++) {
    const int kl0 = l0 - 128 + kt * 32;
    if (kl0 < 0) continue;
    const int ks0 = r * L + kl0;
    f32x16 s;
#pragma unroll
    for (int i = 0; i < 16; i++) s[i] = 0.f;
#pragma unroll
    for (int ch = 0; ch < 4; ch++) {
      bf16x8 kf = *(const bf16x8*)(Kb + (size_t)(ks0 + c) * 64 + ch * 16 + hi * 8);
      s = __builtin_amdgcn_mfma_f32_32x32x16_bf16(kf, qf[ch], s, 0, 0, 0);
    }
    if (kt == 4) {
#pragma unroll
      for (int i = 0; i < 16; i++) { int key = (i >> 2) * 8 + hi * 4 + (i & 3); if (key > c) s[i] = -INFINITY; }
    }
    if (kt == 0) {
#pragma unroll
      for (int i = 0; i < 16; i++) { int key = (i >> 2) * 8 + hi * 4 + (i & 3); if (key < c) s[i] = -INFINITY; }
    }
    float mx = s[0];
#pragma unroll
    for (int i = 1; i < 16; i++) mx = fmaxf(mx, s[i]);
    mx = fmaxf(mx, xor32_(mx, lane));
    const float mnew = fmaxf(mrun, mx);
    const float alpha = __expf(mrun - mnew);
    float p[16];
    float ps = 0.f;
#pragma unroll
    for (int i = 0; i < 16; i++) { p[i] = __expf(s[i] - mnew); ps += p[i]; }
    ps += xor32_(ps, lane);
    lrun = lrun * alpha + ps;
    mrun = mnew;
#pragma unroll
    for (int i = 0; i < 16; i++) { o0[i] *= alpha; o1[i] *= alpha; }
#pragma unroll
    for (int j = 0; j < 2; j++) {
      bf16x8 pf;
#pragma unroll
      for (int i = 0; i < 8; i++) pf[i] = (short)f2bf(p[8 * j + i]);
#pragma unroll
      for (int dt = 0; dt < 2; dt++) {
        const u16* vp = Vb + (size_t)(dt * 32 + c) * 8192 + ks0 + 16 * j + hi * 4;
        uint2 v0 = *(const uint2*)vp;
        uint2 v1 = *(const uint2*)(vp + 8);
        union { uint4 u; bf16x8 b; } cv;
        cv.u = make_uint4(v0.x, v0.y, v1.x, v1.y);
        if (dt == 0) o0 = __builtin_amdgcn_mfma_f32_32x32x16_bf16(cv.b, pf, o0, 0, 0, 0);
        else o1 = __builtin_amdgcn_mfma_f32_32x32x16_bf16(cv.b, pf, o1, 0, 0, 0);
      }
    }
  }
  const float inv = 1.f / lrun;
  const int lq = l0 + c;
  const int t = lq * dil + r;
  const int m = n * 8192 + t;
  float* od = ((float*)(P.ws + OFF_OA)) + ((size_t)m * 6 + head) * 64;
#pragma unroll
  for (int g4 = 0; g4 < 4; g4++) {
    *(float4*)(od + g4 * 8 + hi * 4) = make_float4(o0[4 * g4] * inv, o0[4 * g4 + 1] * inv, o0[4 * g4 + 2] * inv, o0[4 * g4 + 3] * inv);
    *(float4*)(od + 32 + g4 * 8 + hi * 4) = make_float4(o1[4 * g4] * inv, o1[4 * g4 + 1] * inv, o1[4 * g4 + 2] * inv, o1[4 * g4 + 3] * inv);
  }
  if (hi == 0) ((float*)(P.ws + OFF_LSE))[(size_t)m * 6 + head] = mrun + __logf(lrun);
}

__device__ void attn_sample_wave(const Params& P, int l, int task) {
  const int lane = tid_() & 63;
  const int head = task % 6, ms = task / 6, t = ms & 7, ns = ms >> 3;
  const int gi = head >> 1, hh = head & 1;
  const int W = (gi == 0) ? 128 : (gi == 1 ? 512 : 2048);
  const int dil = (gi == 0) ? 1 : (gi == 1 ? 4 : 16);
  const size_t offs = (gi == 0) ? O_KV128S : (gi == 1 ? O_KV512S : O_KV2048S);
  const float* cache = P.in[5 + gi] + ((size_t)(l * 32 + ns) * W) * 256;
  const float* outkv = P.out + offs + ((size_t)(l * 32 + ns) * W) * 256;
  const float q = ((float*)(P.ws + OFF_QSAMP))[((size_t)ms * 6 + head) * 64 + lane];
  float mrun = -INFINITY, lrun = 0.f, o = 0.f;
  for (int j = 0; j <= 128; j++) {
    int idx = W + t - dil * j;
    const float* row = (idx >= W) ? (outkv + (size_t)(idx - 8) * 256) : (cache + (size_t)idx * 256);
    float kx = row[hh * 64 + lane], vx = row[128 + hh * 64 + lane];
    float s = wave_sum(q * kx);
    float mnew = fmaxf(mrun, s);
    float alpha = __expf(mrun - mnew), p = __expf(s - mnew);
    lrun = lrun * alpha + p;
    o = o * alpha + p * vx;
    mrun = mnew;
  }
  const int m = MP + ms;
  ((float*)(P.ws + OFF_OA))[((size_t)m * 6 + head) * 64 + lane] = o / lrun;
  if (lane == 0) ((float*)(P.ws + OFF_LSE))[(size_t)m * 6 + head] = mrun + __logf(lrun);
}

__device__ void phase_scan_attn(const Params& P, int l, char* smem) {
  const int wid = tid_() >> 6;
  float* lds = (float*)smem + wid * (CH * 384);
  const int nblk = gridDim.x;
  const int bid = bid_();
  if (wid < 3) {
    for (int wt = bid * 3 + wid; wt < 768; wt += nblk * 3) {
      if (wt & 1) scan_wave<1>(P, l, wt, lds); else scan_wave<0>(P, l, wt, lds);
    }
  } else {
    const int nw = nblk * 5;
    for (int t = bid * 5 + (wid - 3); t < 192 + 3072 + 1536; t += nw) {
      if (t < 192) scan_wave<2>(P, l, t, lds);
      else if (t < 192 + 3072) attn_prompt_wave(P, t - 192);
      else attn_sample_wave(P, l, t - 192 - 3072);
    }
  }
}

__device__ void phase_combine(const Params& P, int l, char* smem) {
  if (bid_() < 12) {
    const int nh = bid_();
    float* sS = (float*)smem;
    float* sQ = sS + 64 * 65;
    const int tid = tid_(), v = tid >> 3, kq = tid & 7;
    f32x4 c0 = {0.f, 0.f, 0.f, 0.f}, c1 = {0.f, 0.f, 0.f, 0.f};
    for (int seg = 0; seg < NSEG; seg++) {
      float* sin = ((float*)(P.ws + OFF_SIN)) + ((size_t)(nh * NSEG + seg) * 64 + v) * 64 + kq * 8;
      *(f32x4*)sin = c0; *(f32x4*)(sin + 4) = c1;
      __syncthreads();
#pragma unroll
      for (int i = 0; i < 4; i++) { sS[v * 65 + kq * 8 + i] = c0[i]; sS[v * 65 + kq * 8 + 4 + i] = c1[i]; }
      const f32x4* qe = (const f32x4*)(((float*)(P.ws + OFF_QEND)) + (size_t)(nh * NSEG + seg) * 4096);
      ((f32x4*)sQ)[tid] = qe[tid];
      ((f32x4*)sQ)[512 + tid] = qe[512 + tid];
      __syncthreads();
      const float* le = ((float*)(P.ws + OFF_LEND)) + ((size_t)(nh * NSEG + seg) * 64 + v) * 64 + kq * 8;
      f32x4 n0 = *(const f32x4*)le, n1 = *(const f32x4*)(le + 4);
      for (int j = 0; j < 64; j++) {
        float a = sS[v * 65 + j];
        const f32x4* qr = (const f32x4*)(sQ + j * 64 + kq * 8);
        n0 += a * qr[0]; n1 += a * qr[1];
      }
      c0 = n0; c1 = n1;
    }
    float* dst = P.out + O_WKVP + (((size_t)l * 12 + nh) * 64 + v) * 64 + kq * 8;
    *(f32x4*)dst = c0; *(f32x4*)(dst + 4) = c1;
  } else {
    const size_t gtid = (size_t)(bid_() - 12) * NTHREADS + tid_();
    const size_t gsz = (size_t)(gridDim.x - 12) * NTHREADS;
    for (size_t i = gtid; i < (size_t)MT * 128; i += gsz) {
      int m = (int)(i >> 7), hh = (int)((i >> 6) & 1), dd = (int)(i & 63);
      float l0 = ((float*)(P.ws + OFF_LSE))[(size_t)m * 6 + hh], l1 = ((float*)(P.ws + OFF_LSE))[(size_t)m * 6 + 2 + hh], l2 = ((float*)(P.ws + OFF_LSE))[(size_t)m * 6 + 4 + hh];
      float mx = fmaxf(l0, fmaxf(l1, l2));
      float w0 = __expf(l0 - mx), w1 = __expf(l1 - mx), w2 = __expf(l2 - mx);
      float inv = 1.f / (w0 + w1 + w2);
      const float* oa = ((float*)(P.ws + OFF_OA)) + (size_t)m * 384;
      float y = (w0 * oa[hh * 64 + dd] + w1 * oa[(2 + hh) * 64 + dd] + w2 * oa[(4 + hh) * 64 + dd]) * inv;
      ((u16*)(P.ws + OFF_DP))[(size_t)m * DPW + 256 + hh * 64 + dd] = f2bf(y);
    }
  }
}

__device__ void phase_correct(const Params& P, int l) {
  const int lane = tid_() & 63;
  const int gw = (bid_() * NTHREADS + tid_()) >> 6;
  const int nw = gridDim.x * (NTHREADS / 64);
  for (int task = gw; task < 12 * NSEG * 4; task += nw) {
    const int qtr = task & 3, g = task >> 2, seg = g & 31, nh = g >> 5, n = nh / 6, h = nh % 6;
    float S[64];
    const float4* sp = (const float4*)(((float*)(P.ws + OFF_SIN)) + ((size_t)(nh * NSEG + seg) * 64 + lane) * 64);
#pragma unroll
    for (int k = 0; k < 16; k++) { float4 v = sp[k]; S[4 * k] = v.x; S[4 * k + 1] = v.y; S[4 * k + 2] = v.z; S[4 * k + 3] = v.w; }
    const int m0 = n * 8192 + seg * SEGLEN + qtr * 64;
    for (int s = 0; s < 64; s++) {
      const int m = m0 + s;
      const float4* q = (const float4*)(((float*)(P.ws + OFF_QT)) + (size_t)m * 384 + h * 64);
      float y = ((float*)(P.ws + OFF_YL))[(size_t)m * 384 + h * 64 + lane];
#pragma unroll
      for (int k = 0; k < 16; k++) {
        float4 q4 = q[k];
        y += S[4 * k] * q4.x; y += S[4 * k + 1] * q4.y; y += S[4 * k + 2] * q4.z; y += S[4 * k + 3] * q4.w;
      }
      rwkv_finalize(P, l, m, h, lane, y);
    }
  }
}

__global__ void __launch_bounds__(NTHREADS, 2) fwd_megakernel(Params P) {
  cg::grid_group grid = cg::this_grid();
  extern __shared__ __attribute__((aligned(16))) char smem[];
  phase_prep0(P, smem);
  grid.sync();
  for (int l = 0; l < 4; l++) {
    phase_rmsnorm(P, P.in[10] + l * DM, false);
    grid.sync();
    { EpiIn E; E.Z = ((float*)(P.ws + OFF_Z)); E.G = ((u16*)(P.ws + OFF_G)); run_gemm(smem, ((u16*)(P.ws + OFF_H)), DM, ((u16*)(P.ws + OFF_W_IN)) + (size_t)l * 5888 * 1024, 1024, 5888, 1024, E); }
    grid.sync();
    phase_prep(P, l);
    grid.sync();
    { EpiLora E; E.LO = ((float*)(P.ws + OFF_LO)); run_gemm(smem, ((u16*)(P.ws + OFF_AL)), 256, ((u16*)(P.ws + OFF_W_LORA)) + (size_t)l * LOW * 256, 256, LOW, 256, E); }
    grid.sync();
    phase_rwkv_prep(P, l);
    grid.sync();
    phase_scan_attn(P, l, smem);
    grid.sync();
    phase_combine(P, l, smem);
    grid.sync();
    phase_correct(P, l);
    grid.sync();
    {
      const u16* Wm = ((u16*)(P.ws + OFF_W_MERGE)) + (size_t)l * 1024 * DPW;
      { EpiMerge<0> E; E.Gt = ((u16*)(P.ws + OFF_G)); E.T = ((float*)(P.ws + OFF_T)); E.MG = ((u16*)(P.ws + OFF_MG)); run_gemm(smem, ((u16*)(P.ws + OFF_DP)), DPW, Wm, DPW, 1024, 256, E); }
      { EpiMerge<1> E; E.Gt = ((u16*)(P.ws + OFF_G)) + 1024; E.T = ((float*)(P.ws + OFF_T)); E.MG = ((u16*)(P.ws + OFF_MG)); run_gemm(smem, ((u16*)(P.ws + OFF_DP)) + 256, DPW, Wm + 256, DPW, 1024, 256, E); }
      { EpiMerge<2> E; E.Gt = ((u16*)(P.ws + OFF_G)) + 2048; E.T = ((float*)(P.ws + OFF_T)); E.MG = ((u16*)(P.ws + OFF_MG)); run_gemm(smem, ((u16*)(P.ws + OFF_DP)) + 512, DPW, Wm + 512, DPW, 1024, 384, E); }
    }
    grid.sync();
    { EpiResid E; E.XF = ((float*)(P.ws + OFF_XF)); run_gemm(smem, ((u16*)(P.ws + OFF_MG)), DM, ((u16*)(P.ws + OFF_W_OUT)) + (size_t)l * 1024 * 1024, 1024, 1024, 1024, E); }
    grid.sync();
    phase_rmsnorm(P, P.in[29] + l * DM, false);
    grid.sync();
    { Epi13 E; E.HID = ((u16*)(P.ws + OFF_HID)); run_gemm(smem, ((u16*)(P.ws + OFF_H)), DM, ((u16*)(P.ws + OFF_W_13)) + (size_t)l * 5632 * 1024, 1024, 5632, 1024, E); }
    grid.sync();
    { EpiResid E; E.XF = ((float*)(P.ws + OFF_XF)); run_gemm(smem, ((u16*)(P.ws + OFF_HID)), 2816, ((u16*)(P.ws + OFF_W_2)) + (size_t)l * 1024 * 2816, 2816, 1024, 2816, E); }
    grid.sync();
    phase_rmsnorm(P, P.in[33] + l * DM, false);
    grid.sync();
    { EpiPG E; E.PG = ((u16*)(P.ws + OFF_PG)); run_gemm(smem, ((u16*)(P.ws + OFF_H)), DM, ((u16*)(P.ws + OFF_W_PG)) + (size_t)l * 1024 * 1024, 1024, 1024, 1024, E); }
    { EpiPP E; E.PG = ((u16*)(P.ws + OFF_PG)); E.XF = ((float*)(P.ws + OFF_XF)); run_gemm(smem, ((u16*)(P.ws + OFF_PB)) + (size_t)l * MT * 256, 256, ((u16*)(P.ws + OFF_W_PP)) + (size_t)l * 1024 * 256, 256, 1024, 256, E); }
    grid.sync();
  }
  phase_rmsnorm(P, P.in[36], true);
}

extern "C" void kernel_launch(void* const* d_in, const int* in_sizes, int n_in, void* d_out, int out_size,
                              void* d_ws, size_t ws_size, hipStream_t stream) {
  static int grid_blocks = 0;
  if (!grid_blocks) {
    int dev = 0, cus = 0, per_cu = 0;
    (void)hipGetDevice(&dev);
    (void)hipDeviceGetAttribute(&cus, hipDeviceAttributeMultiprocessorCount, dev);
    if (hipFuncSetAttribute((const void*)fwd_megakernel, hipFuncAttributeMaxDynamicSharedMemorySize, SMEM_BYTES) != hipSuccess)
      fprintf(stderr, "hipFuncSetAttribute failed\n");
    (void)hipOccupancyMaxActiveBlocksPerMultiprocessor(&per_cu, fwd_megakernel, NTHREADS, SMEM_BYTES);
    if (per_cu < 1) fprintf(stderr, "occupancy query says %d blocks/CU\n", per_cu);
    grid_blocks = cus;
  }
  Params P;
  memset(&P, 0, sizeof(P));
  for (int i = 0; i < 37; i++) P.in[i] = (const float*)d_in[i];
  P.out = (float*)d_out;
  P.ws = (char*)d_ws;
  if (WS_TOTAL > ws_size) { fprintf(stderr, "workspace too small: need %zu have %zu\n", (size_t)WS_TOTAL, ws_size); return; }
  void* args[] = {&P};
  hipError_t e = hipLaunchCooperativeKernel((void*)fwd_megakernel, dim3(grid_blocks), dim3(NTHREADS), args, SMEM_BYTES, stream);
  if (e != hipSuccess) fprintf(stderr, "cooperative launch failed: %s (grid %d)\n", hipGetErrorString(e), grid_blocks);
}
```

```cpp
#include <hip/hip_runtime.h>
#include <hip/hip_cooperative_groups.h>
#include <cstdio>
#include <cstdint>
#include <cstring>
namespace cg = cooperative_groups;

typedef unsigned short u16;
typedef __attribute__((ext_vector_type(8))) short bf16x8;
typedef __attribute__((ext_vector_type(4))) float f32x4;
typedef __attribute__((ext_vector_type(16))) float f32x16;
typedef __attribute__((ext_vector_type(4))) unsigned u32x4;

#define DM 1024
#define MP 16384
#define MS 256
#define MT 16640
#define NMT 130
#define ZW 2816
#define GW 3072
#define NSEG 32
#define SEGLEN 256
#define NTHREADS 512
#define DPW 896
#define LOW 1280

struct Params {
  const float* in[37];
  float* out;
  char* ws;
};
constexpr size_t al256(size_t x) { return (x + 255) & ~(size_t)255; }
constexpr size_t OFF_XF = 0;
constexpr size_t OFF_H = OFF_XF + al256((size_t)MT*DM*4);
constexpr size_t OFF_Z = OFF_H + al256((size_t)MT*DM*2);
constexpr size_t OFF_G = OFF_Z + al256((size_t)MT*ZW*4);
constexpr size_t OFF_DP = OFF_G + al256((size_t)MT*GW*2);
constexpr size_t OFF_AL = OFF_DP + al256((size_t)MT*DPW*2);
constexpr size_t OFF_LO = OFF_AL + al256((size_t)MT*256*2);
constexpr size_t OFF_SC = OFF_LO + al256((size_t)MT*LOW*4);
constexpr size_t OFF_BON = OFF_SC + al256((size_t)MT*2304*4);
constexpr size_t OFF_YL = OFF_BON + al256((size_t)MT*6*4);
constexpr size_t OFF_QT = OFF_YL + al256((size_t)MP*384*4);
constexpr size_t OFF_LEND = OFF_QT + al256((size_t)MP*384*4);
constexpr size_t OFF_QEND = OFF_LEND + al256((size_t)12*NSEG*4096*4);
constexpr size_t OFF_SIN = OFF_QEND + al256((size_t)12*NSEG*4096*4);
constexpr size_t OFF_QS_ = OFF_SIN + al256((size_t)12*NSEG*4096*4);
constexpr size_t OFF_KS_ = OFF_QS_ + al256((size_t)MP*384*2);
constexpr size_t OFF_VT = OFF_KS_ + al256((size_t)MP*384*2);
constexpr size_t OFF_QSAMP = OFF_VT + al256((size_t)MP*384*2);
constexpr size_t OFF_OA = OFF_QSAMP + al256((size_t)MS*384*4);
constexpr size_t OFF_LSE = OFF_OA + al256((size_t)MT*384*4);
constexpr size_t OFF_MG = OFF_LSE + al256((size_t)MT*6*4);
constexpr size_t OFF_PB = OFF_MG + al256((size_t)MT*DM*2);
constexpr size_t OFF_ROPE = OFF_PB + al256((size_t)4*MT*256*2);
constexpr size_t OFF_W_IN = OFF_ROPE + al256((size_t)8200*64*4);
constexpr size_t OFF_W_LORA = OFF_W_IN + al256((size_t)4*5888*1024*2);
constexpr size_t OFF_W_MERGE = OFF_W_LORA + al256((size_t)4*LOW*256*2);
constexpr size_t OFF_W_OUT = OFF_W_MERGE + al256((size_t)4*1024*DPW*2);
constexpr size_t OFF_W_13 = OFF_W_OUT + al256((size_t)4*1024*1024*2);
constexpr size_t OFF_W_2 = OFF_W_13 + al256((size_t)4*5632*1024*2);
constexpr size_t OFF_W_PG = OFF_W_2 + al256((size_t)4*1024*2816*2);
constexpr size_t OFF_W_PP = OFF_W_PG + al256((size_t)4*1024*1024*2);
constexpr size_t WS_TOTAL = OFF_W_PP + al256((size_t)4*1024*256*2);
constexpr size_t OFF_HID = OFF_Z, OFF_T = OFF_Z, OFF_PG = OFF_Z + (size_t)100 * 1024 * 1024;


#define O_YP 0
#define O_YS 16777216
#define O_POOLP 17039360
#define O_POOLS 17070080
#define O_SHIFTP 17561600
#define O_SHIFTS 17572864
#define O_WKVP 17753088
#define O_WKVS 17949696
#define O_KV128P 21095424
#define O_KV128S 21357568
#define O_KV512P 25551872
#define O_KV512S 26600448
#define O_KV2048P 43377664
#define O_KV2048S 47571968

__device__ __forceinline__ int tid_() { int t = threadIdx.x; asm volatile("" : "+v"(t)); return t; }
__device__ __forceinline__ int bid_() { int b = blockIdx.x; asm volatile("" : "+s"(b)); return b; }
__device__ __forceinline__ u16 f2bf(float f) {
  unsigned u = __float_as_uint(f);
  u += 0x7fffu + ((u >> 16) & 1u);
  return (u16)(u >> 16);
}
__device__ __forceinline__ float bf2f(u16 h) { return __uint_as_float(((unsigned)h) << 16); }
__device__ __forceinline__ float sigmoidf_(float x) { return 1.f / (1.f + __expf(-x)); }
__device__ __forceinline__ float dpp_add_(float v, const int ctrl_sel) {
  int iv = __float_as_int(v), r;
  if (ctrl_sel == 0) r = __builtin_amdgcn_update_dpp(0, iv, 0xB1, 0xF, 0xF, true);
  else if (ctrl_sel == 1) r = __builtin_amdgcn_update_dpp(0, iv, 0x4E, 0xF, 0xF, true);
  else if (ctrl_sel == 2) r = __builtin_amdgcn_update_dpp(0, iv, 0x141, 0xF, 0xF, true);
  else r = __builtin_amdgcn_update_dpp(0, iv, 0x140, 0xF, 0xF, true);
  return v + __int_as_float(r);
}
__device__ __forceinline__ float wave_sum(float v) {
  v = dpp_add_(v, 0); v = dpp_add_(v, 1); v = dpp_add_(v, 2); v = dpp_add_(v, 3);
  int iv = __float_as_int(v);
  float a = __int_as_float(__builtin_amdgcn_readlane(iv, 0)), b = __int_as_float(__builtin_amdgcn_readlane(iv, 16));
  float c = __int_as_float(__builtin_amdgcn_readlane(iv, 32)), d = __int_as_float(__builtin_amdgcn_readlane(iv, 48));
  return (a + b) + (c + d);
}
__device__ __forceinline__ float xor32_(float v, int lane) {
  return __int_as_float(__builtin_amdgcn_ds_bpermute((lane ^ 32) << 2, __float_as_int(v)));
}

template <int U, class T, class LoadF, class StoreF>
__device__ __forceinline__ void batched(size_t n, size_t gtid, size_t gsz, LoadF ld, StoreF st) {
  size_t i = gtid;
  for (; i + (size_t)(U - 1) * gsz < n; i += (size_t)U * gsz) {
    T v[U];
#pragma unroll
    for (int u = 0; u < U; u++) v[u] = ld(i + (size_t)u * gsz);
#pragma unroll
    for (int u = 0; u < U; u++) st(i + (size_t)u * gsz, v[u]);
  }
  for (; i < n; i += gsz) st(i, ld(i));
}

#define LROW 72
#define SMEM_BYTES 131072
namespace pg8 {
#define PG8_LAS __attribute__((address_space(3)))
typedef unsigned short bf16_t;
constexpr int BM = 256, BK = 64, HALF = 128, HTB = HALF * BK * 2  , STAGE_BYTES = 8 * HTB, NXCD = 8, WGM = 8;

__host__ __device__ __forceinline__ int lds_byte(int r, int c) { const int st = (r >> 4) * 2 + (c >> 5), rr = r & 15, cc = c & 31, ob = rr * 64 + cc * 2; return st * 1024 + (ob ^ (((ob >> 9) & 1) << 5)); }
__host__ __device__ __forceinline__ void stage_rc(int b, int& R, int& C) { const int st = b / 1024, sb = b % 1024, swz = sb ^ (((sb >> 9) & 1) << 5); R = (st >> 1) * 16 + swz / 64; C = (st & 1) * 32 + (swz % 64) / 2; }
__host__ __device__ __forceinline__ int perm32(int rho) { const int n = rho >> 4, i = rho & 15; return 8 * (i >> 2) + 4 * n + (i & 3); }

struct Unit { int pm, pn; };
struct Gemm { const bf16_t* A; const bf16_t* Bt; int M, N, K, lda, ldb; };

struct StaticOrder {
    int nM, nN, nwg, G, c;
    __host__ __device__ void init(int M, int N, int G_, int c_) { nM = M / BM; nN = N / BM; nwg = nM * nN; G = G_; c = c_; }
    __host__ __device__ bool next(int i, Unit& u) const {
        const long L = (long)i * G + c; if (L >= nwg) return false;
        int wgid = (int)L; { const int q = nwg / NXCD, r = nwg % NXCD, xcd = wgid % NXCD, off = wgid / NXCD; wgid = (xcd < r ? xcd * (q + 1) : r * (q + 1) + (xcd - r) * q) + off; }
        const int nig = WGM * nN, gid = wgid / nig, fm = gid * WGM, gsz = (nM - fm) < WGM ? (nM - fm) : WGM;
        u.pm = fm + ((wgid % nig) % gsz); u.pn = (wgid % nig) / gsz; return true;
    }
    __device__ __forceinline__ void a_ready(const Unit&) const {}
    __device__ __forceinline__ void done(const Unit&) const {}
};
template <class Epi, class Sched, bool STAMP = false>
__device__ __forceinline__ void gemm_phase(PG8_LAS unsigned char* lds, const Gemm g, const Sched& S, const Epi& E, unsigned long long* stamps) {
    const int tid = tid_(), wid = __builtin_amdgcn_readfirstlane(tid >> 6), lane = tid & 63, wr = wid >> 2, wc = wid & 3, fr = lane & 15, fq = lane >> 4;
    const int K = g.K, nt = K / BK;

#define PG8_STAMP() do {} while (0)
    PG8_STAMP();
    unsigned voffA[2], voffB[2];
#pragma unroll
    for (int i = 0; i < 2; ++i) { int R, C; stage_rc(tid * 16 + i * 8192, R, C); const int Rb = Epi::PERM ? ((R & ~31) + perm32(R & 31)) : R;
        voffA[i] = (unsigned)(R * g.lda + C) * 2u; voffB[i] = (unsigned)(Rb * g.ldb + C) * 2u; }
    const size_t kstep = (size_t)(BK * 2);
    const size_t hstepA = (size_t)HALF * g.lda * 2, hstepB = (size_t)HALF * g.ldb * 2;
    const size_t tstepA = 2 * hstepA, tstepB = 2 * hstepB;
    const unsigned ldsw = (unsigned)wid * 1024u;
    const int aoff = lds_byte(wr * 64 + fr, fq * 8), boff = lds_byte(wc * 32 + fr, fq * 8);
#define PG8_SA(b, h) (((b) * 2 + (h)) * HTB)
#define PG8_SB(b, h) ((4 + (b) * 2 + (h)) * HTB)
#define PG8_STAGE(bufoff, gbase, voff) do { _Pragma("unroll") for (int _i = 0; _i < 2; ++_i) \
        __builtin_amdgcn_global_load_lds((const unsigned*)((const char*)(gbase) + (voff)[_i]), (PG8_LAS unsigned*)(lds + (bufoff) + ldsw + _i * 8192), 16, 0, 0); } while (0)
#define PG8_LDA(dst, b, h) do { _Pragma("unroll") for (int m = 0; m < 4; ++m) _Pragma("unroll") for (int k = 0; k < 2; ++k) dst[m][k] = *(const PG8_LAS bf16x8*)(lds + PG8_SA(b, h) + aoff + m * 2048 + k * 1024); } while (0)
#define PG8_LDB(dst, b, h) do { _Pragma("unroll") for (int n = 0; n < 2; ++n) _Pragma("unroll") for (int k = 0; k < 2; ++k) dst[n][k] = *(const PG8_LAS bf16x8*)(lds + PG8_SB(b, h) + boff + n * 2048 + k * 1024); } while (0)
#define PG8_MMA(ai, bj, At, Bt) do { __builtin_amdgcn_s_setprio(1); _Pragma("unroll") for (int m = 0; m < 4; ++m) _Pragma("unroll") for (int n = 0; n < 2; ++n) _Pragma("unroll") for (int k = 0; k < 2; ++k) \
        acc[ai][bj][m][n] = __builtin_amdgcn_mfma_f32_16x16x32_bf16(Bt[n][k], At[m][k], acc[ai][bj][m][n], 0, 0, 0); __builtin_amdgcn_s_setprio(0); } while (0)
#define PG8_WAIT_V(n) asm volatile("s_waitcnt vmcnt(" #n ")" ::: "memory")
#define PG8_WAIT_L(n) asm volatile("s_waitcnt lgkmcnt(" #n ")" ::: "memory")
#define PG8_BAR __builtin_amdgcn_s_barrier()
#define PG8_SCHED __builtin_amdgcn_sched_barrier(0)
    Unit cur, nxt; int ui = 0;
    if (!S.next(0, cur)) return;
    f32x4 acc[2][2][4][2];
#pragma unroll
    for (int a = 0; a < 2; ++a)
#pragma unroll
        for (int b = 0; b < 2; ++b)
#pragma unroll
            for (int m = 0; m < 4; ++m)
#pragma unroll
                for (int n = 0; n < 2; ++n) acc[a][b][m][n] = (f32x4){0.f, 0.f, 0.f, 0.f};
    bf16x8 At[4][2], B0[2][2], B1[2][2];
    const char* cA = (const char*)g.A + (size_t)cur.pm * tstepA; const char* cB = (const char*)g.Bt + (size_t)cur.pn * tstepB;
    S.a_ready(cur);
    PG8_STAGE(PG8_SB(0, 0), cB, voffB); PG8_STAGE(PG8_SA(0, 0), cA, voffA); PG8_STAGE(PG8_SB(0, 1), cB + hstepB, voffB); PG8_STAGE(PG8_SA(0, 1), cA + hstepA, voffA);
    if (wr == 1) PG8_BAR;
    PG8_WAIT_V(4); PG8_BAR;
    PG8_STAGE(PG8_SB(1, 0), cB + kstep, voffB); PG8_STAGE(PG8_SA(1, 0), cA + kstep, voffA); PG8_STAGE(PG8_SB(1, 1), cB + hstepB + kstep, voffB);
    PG8_WAIT_V(6); PG8_BAR;
    PG8_STAMP();
    for (;;) {
        const bool has_next = S.next(ui + 1, nxt);
        const char* nA = has_next ? (const char*)g.A + (size_t)nxt.pm * tstepA : cA; const char* nB = has_next ? (const char*)g.Bt + (size_t)nxt.pn * tstepB : cB;
#pragma unroll 1
        for (int t = 0; t < nt; t += 2) {
            const bool last = (t == nt - 2);
            const char* a1 = cA + (size_t)(t + 1) * kstep;
            const char* a2 = last ? nA : cA + (size_t)(t + 2) * kstep; const char* b2 = last ? nB : cB + (size_t)(t + 2) * kstep;
            const char* a3 = a2 + kstep; const char* b3 = b2 + kstep;
            if (last && has_next) S.a_ready(nxt);
            PG8_LDB(B0, 0, 0); PG8_SCHED; PG8_LDA(At, 0, 0); PG8_STAGE(PG8_SA(1, 1), a1 + hstepA, voffA);
            PG8_WAIT_L(8); PG8_BAR; PG8_WAIT_L(0); PG8_MMA(0, 0, At, B0); PG8_BAR; PG8_SCHED;
            PG8_LDB(B1, 0, 1); PG8_STAGE(PG8_SB(0, 0), b2, voffB);
            PG8_BAR; PG8_WAIT_L(0); PG8_MMA(0, 1, At, B1); PG8_BAR;
            PG8_LDA(At, 0, 1); PG8_STAGE(PG8_SA(0, 0), a2, voffA);
            PG8_BAR; PG8_WAIT_L(0); PG8_MMA(1, 0, At, B0); PG8_BAR; PG8_SCHED;
            PG8_STAGE(PG8_SB(0, 1), b2 + hstepB, voffB);
            PG8_WAIT_V(6); PG8_BAR; PG8_MMA(1, 1, At, B1); PG8_BAR;
            PG8_LDB(B0, 1, 0); PG8_SCHED; PG8_LDA(At, 1, 0); PG8_STAGE(PG8_SA(0, 1), a2 + hstepA, voffA);
            PG8_WAIT_L(8); PG8_BAR; PG8_WAIT_L(0); PG8_MMA(0, 0, At, B0); PG8_BAR; PG8_SCHED;
            PG8_LDB(B1, 1, 1); PG8_STAGE(PG8_SB(1, 0), b3, voffB);
            PG8_BAR; PG8_WAIT_L(0); PG8_MMA(0, 1, At, B1); PG8_BAR;
            PG8_LDA(At, 1, 1); PG8_STAGE(PG8_SA(1, 0), a3, voffA);
            PG8_BAR; PG8_WAIT_L(0); PG8_MMA(1, 0, At, B0); PG8_BAR; PG8_SCHED;
            PG8_STAGE(PG8_SB(1, 1), b3 + hstepB, voffB);
            PG8_WAIT_V(6); PG8_BAR; PG8_MMA(1, 1, At, B1); PG8_BAR;
        }
        PG8_STAMP();
        if constexpr (!Epi::AFTER_DRAIN) { E(acc, cur, wr, wc, fr, fq); S.done(cur); }
        PG8_STAMP();
        if (!has_next) break;
#pragma unroll
        for (int a = 0; a < 2; ++a)
#pragma unroll
            for (int b = 0; b < 2; ++b)
#pragma unroll
                for (int m = 0; m < 4; ++m)
#pragma unroll
                    for (int n = 0; n < 2; ++n) acc[a][b][m][n] = (f32x4){0.f, 0.f, 0.f, 0.f};
        cur = nxt; cA = nA; cB = nB; ++ui;
    }
    PG8_WAIT_V(0);
    if (wr == 0) PG8_BAR;
    PG8_BAR;
    if constexpr (Epi::AFTER_DRAIN) { E.fused(acc, cur, wr, wc, fr, fq, lds, wid, lane); S.done(cur); }
    PG8_STAMP();
#undef PG8_STAMP
#undef PG8_SA
#undef PG8_SB
#undef PG8_STAGE
#undef PG8_LDA
#undef PG8_LDB
#undef PG8_MMA
#undef PG8_WAIT_V
#undef PG8_WAIT_L
#undef PG8_BAR
#undef PG8_SCHED
}
}

#include <cstdio>
#include <ctime>
#include <cstdlib>
#include <cstring>

__device__ __forceinline__ void transpose_w(const float* src, int K, int N, u16* dst, int ldb, int koff, int mode, char* smem) {
  float* t = (float*)smem;
  const int tk = K >> 6, tn = N >> 6;
  const int tid = tid_();
  for (int tile = bid_(); tile < tk * tn; tile += gridDim.x) {
    const int k0 = (tile / tn) * 64, n0 = (tile % tn) * 64;
    __syncthreads();
#pragma unroll
    for (int p = 0; p < 2; p++) {
      int i = (tid >> 4) + 32 * p, j4 = (tid & 15) * 4;
      float4 v = *(const float4*)(src + (size_t)(k0 + i) * N + n0 + j4);
      t[i * 65 + j4] = v.x; t[i * 65 + j4 + 1] = v.y; t[i * 65 + j4 + 2] = v.z; t[i * 65 + j4 + 3] = v.w;
    }
    __syncthreads();
    {
      int n = (tid >> 3), ks = (tid & 7) * 8;
      u32x4 w;
#pragma unroll
      for (int q = 0; q < 4; q++) {
        u16 lo = f2bf(t[(ks + 2 * q) * 65 + n]);
        u16 hi = f2bf(t[(ks + 2 * q + 1) * 65 + n]);
        w[q] = (unsigned)lo | ((unsigned)hi << 16);
      }
      int gn = n0 + n;
      int row = gn;
      if (mode == 1) row = (gn >> 7) * 256 + (gn & 127);
      else if (mode == 2) row = (gn >> 7) * 256 + 128 + (gn & 127);
      *(u32x4*)(dst + (size_t)row * ldb + koff + k0 + ks) = w;
    }
  }
}

__device__ __forceinline__ void phase_prep0(const Params& P, char* smem) {
  const size_t gtid = (size_t)bid_() * NTHREADS + tid_();
  const size_t gsz = (size_t)gridDim.x * NTHREADS;
  {
    const f32x4* xp = (const f32x4*)P.in[0];
    const f32x4* xs = (const f32x4*)P.in[1];
    f32x4* xf = (f32x4*)((float*)(P.ws + OFF_XF));
    const size_t np = (size_t)MP * DM / 4, ns = (size_t)MS * DM / 4;
    batched<8, f32x4>(np + ns, gtid, gsz,
      [&](size_t i) { return (i < np) ? __builtin_nontemporal_load(xp + i) : __builtin_nontemporal_load(xs + (i - np)); },
      [&](size_t i, f32x4 v) { xf[i] = v; });
  }
  {
    const size_t per = (size_t)MT * 256 / 4;
    u16* pb = ((u16*)(P.ws + OFF_PB));
    batched<8, f32x4>(4 * per, gtid, gsz,
      [&](size_t i) {
        int l = (int)(i / per);
        size_t e = (i % per) * 4;
        return (e < (size_t)MP * 256) ? __builtin_nontemporal_load((const f32x4*)(P.in[8] + (size_t)l * MP * 256 + e))
                                      : __builtin_nontemporal_load((const f32x4*)(P.in[9] + (size_t)l * MS * 256 + (e - (size_t)MP * 256)));
      },
      [&](size_t i, f32x4 v) {
        uint2 o;
        o.x = (unsigned)f2bf(v[0]) | ((unsigned)f2bf(v[1]) << 16);
        o.y = (unsigned)f2bf(v[2]) | ((unsigned)f2bf(v[3]) << 16);
        *(uint2*)(pb + i * 4) = o;
      });
  }
  {
    for (int g = 0; g < 3; g++) {
      const int W = (g == 0) ? 128 : (g == 1 ? 512 : 2048);
      const size_t ofs = (g == 0) ? O_KV128S : (g == 1 ? O_KV512S : O_KV2048S);
      const f32x4* src = (const f32x4*)P.in[5 + g];
      f32x4* dst = (f32x4*)(P.out + ofs);
      const size_t rowsPer = (size_t)(W - 8) * 64;
      const size_t total = 128 * rowsPer;
      batched<8, f32x4>(total, gtid, gsz,
        [&](size_t i) { size_t ln = i / rowsPer, r = i % rowsPer; return __builtin_nontemporal_load(src + ln * (size_t)W * 64 + 8 * 64 + r); },
        [&](size_t i, f32x4 v) { size_t ln = i / rowsPer, r = i % rowsPer; __builtin_nontemporal_store(v, dst + ln * (size_t)W * 64 + r); });
    }
  }
  {
    for (size_t i = gtid; i < 8200 * 32; i += gsz) {
      int pos = (int)(i >> 5), fi = (int)(i & 31);
      float inv = powf(10000.0f, -2.0f * (float)fi / 64.0f);
      float ang = (float)pos * inv;
      double rev = (double)ang * 0.15915494309189533577;
      rev -= rint(rev);
      float rf = (float)rev;
      ((float*)(P.ws + OFF_ROPE))[i * 2] = __builtin_amdgcn_cosf(rf);
      ((float*)(P.ws + OFF_ROPE))[i * 2 + 1] = __builtin_amdgcn_sinf(rf);
    }
  }
  for (size_t i = gtid; i < (size_t)MT * 128; i += gsz) {
    size_t m = i >> 7, c = i & 127;
    ((u16*)(P.ws + OFF_DP))[m * DPW + 384 + c] = 0;
  }
  for (int l = 0; l < 4; l++) {
    u16* wl = ((u16*)(P.ws + OFF_W_LORA)) + (size_t)l * LOW * 256;
    const float* w2 = P.in[16] + (size_t)l * 64 * 384;
    const float* a2 = P.in[18] + (size_t)l * 64 * 384;
    const float* g2 = P.in[19] + (size_t)l * 128 * 384;
    for (size_t i = gtid; i < LOW * 256; i += gsz) {
      int k = (int)(i / LOW), n = (int)(i % LOW);
      float v = 0.f;
      if (n < 384) { if (k < 64) v = w2[k * 384 + n]; }
      else if (n < 768) { if (k >= 64 && k < 128) v = a2[(k - 64) * 384 + (n - 384)]; }
      else if (n < 1152) { if (k >= 128) v = g2[(k - 128) * 384 + (n - 768)]; }
      wl[(size_t)n * 256 + k] = f2bf(v);
    }
    u16* wm = ((u16*)(P.ws + OFF_W_MERGE)) + (size_t)l * 1024 * DPW;
    const float* wg = P.in[12] + (size_t)l * 4 * 64 * 64;
    const float* sc = P.in[13] + (size_t)l * 256;
    const float* pp = P.in[25] + (size_t)l * 256 * 1024;
    for (size_t i = gtid; i < 256 * 1024; i += gsz) {
      int k = (int)(i >> 10), n = (int)(i & 1023);
      int g = k >> 6, c = k & 63;
      float s = 0.f;
      for (int j = 0; j < 64; j++) s += wg[(g * 64 + c) * 64 + j] * sc[g * 64 + j] * pp[(size_t)(g * 64 + j) * 1024 + n];
      wm[(size_t)n * DPW + k] = f2bf(s);
    }
    for (size_t i = gtid; i < 128 * 1024; i += gsz) {
      int k = (int)(i & 127), n = (int)(i >> 7);
      wm[(size_t)n * DPW + 384 + k] = 0;
    }
  }
  for (int l = 0; l < 4; l++) {
    transpose_w(P.in[11] + (size_t)l * 1024 * 5888, 1024, 5888, ((u16*)(P.ws + OFF_W_IN)) + (size_t)l * 5888 * 1024, 1024, 0, 0, smem);
    transpose_w(P.in[26] + (size_t)l * 128 * 1024, 128, 1024, ((u16*)(P.ws + OFF_W_MERGE)) + (size_t)l * 1024 * DPW, DPW, 256, 0, smem);
    transpose_w(P.in[27] + (size_t)l * 384 * 1024, 384, 1024, ((u16*)(P.ws + OFF_W_MERGE)) + (size_t)l * 1024 * DPW, DPW, 512, 0, smem);
    transpose_w(P.in[28] + (size_t)l * 1024 * 1024, 1024, 1024, ((u16*)(P.ws + OFF_W_OUT)) + (size_t)l * 1024 * 1024, 1024, 0, 0, smem);
    transpose_w(P.in[30] + (size_t)l * 1024 * 2816, 1024, 2816, ((u16*)(P.ws + OFF_W_13)) + (size_t)l * 5632 * 1024, 1024, 0, 1, smem);
    transpose_w(P.in[31] + (size_t)l * 1024 * 2816, 1024, 2816, ((u16*)(P.ws + OFF_W_13)) + (size_t)l * 5632 * 1024, 1024, 0, 2, smem);
    transpose_w(P.in[32] + (size_t)l * 2816 * 1024, 2816, 1024, ((u16*)(P.ws + OFF_W_2)) + (size_t)l * 1024 * 2816, 2816, 0, 0, smem);
    transpose_w(P.in[35] + (size_t)l * 1024 * 1024, 1024, 1024, ((u16*)(P.ws + OFF_W_PG)) + (size_t)l * 1024 * 1024, 1024, 0, 0, smem);
    transpose_w(P.in[34] + (size_t)l * 256 * 1024, 256, 1024, ((u16*)(P.ws + OFF_W_PP)) + (size_t)l * 1024 * 256, 256, 0, 0, smem);
  }
}

__device__ __forceinline__ void phase_rmsnorm(const Params& P, const float* g, bool final_) {
  const int lane = tid_() & 63;
  const int gw = (bid_() * NTHREADS + tid_()) >> 6;
  const int nw = gridDim.x * (NTHREADS / 64);
  for (int m = gw; m < MT; m += nw) {
    const float4* x = (const float4*)(((float*)(P.ws + OFF_XF)) + (size_t)m * DM);
    float4 v[4];
    float ss = 0.f;
#pragma unroll
    for (int p = 0; p < 4; p++) {
      v[p] = x[p * 64 + lane];
      ss += v[p].x * v[p].x + v[p].y * v[p].y + v[p].z * v[p].z + v[p].w * v[p].w;
    }
    ss = wave_sum(ss);
    float rstd = rsqrtf(ss * (1.f / DM) + 1e-6f);
#pragma unroll
    for (int p = 0; p < 4; p++) {
      float4 gg = ((const float4*)g)[p * 64 + lane];
      float a = v[p].x * rstd * gg.x, b = v[p].y * rstd * gg.y, c = v[p].z * rstd * gg.z, d = v[p].w * rstd * gg.w;
      if (final_) {
        float* o = (m < MP) ? (P.out + O_YP + (size_t)m * DM) : (P.out + O_YS + (size_t)(m - MP) * DM);
        ((float4*)o)[p * 64 + lane] = make_float4(a, b, c, d);
      } else {
        uint2 o;
        o.x = (unsigned)f2bf(a) | ((unsigned)f2bf(b) << 16);
        o.y = (unsigned)f2bf(c) | ((unsigned)f2bf(d) << 16);
        ((uint2*)(((u16*)(P.ws + OFF_H)) + (size_t)m * DM))[p * 64 + lane] = o;
      }
    }
  }
}

typedef f32x4 acc_t[2][2][4][2];
__device__ __forceinline__ u32x4 pack8(f32x4 a, f32x4 b) {
  u32x4 r;
  r[0] = (unsigned)f2bf(a[0]) | ((unsigned)f2bf(a[1]) << 16);
  r[1] = (unsigned)f2bf(a[2]) | ((unsigned)f2bf(a[3]) << 16);
  r[2] = (unsigned)f2bf(b[0]) | ((unsigned)f2bf(b[1]) << 16);
  r[3] = (unsigned)f2bf(b[2]) | ((unsigned)f2bf(b[3]) << 16);
  return r;
}
__device__ __forceinline__ void unpack8(u32x4 g, f32x4& a, f32x4& b) {
  a[0] = __uint_as_float(g[0] << 16); a[1] = __uint_as_float(g[0] & 0xffff0000u);
  a[2] = __uint_as_float(g[1] << 16); a[3] = __uint_as_float(g[1] & 0xffff0000u);
  b[0] = __uint_as_float(g[2] << 16); b[1] = __uint_as_float(g[2] & 0xffff0000u);
  b[2] = __uint_as_float(g[3] << 16); b[3] = __uint_as_float(g[3] & 0xffff0000u);
}
__device__ __forceinline__ f32x4 sig4(f32x4 v) { f32x4 r; r[0] = sigmoidf_(v[0]); r[1] = sigmoidf_(v[1]); r[2] = sigmoidf_(v[2]); r[3] = sigmoidf_(v[3]); return r; }

#define EPI_LOOP(...)                                                                   \
  {                                                                                     \
    int _fr = fr, _fq = fq;                                                             \
    asm volatile("" : "+v"(_fr), "+v"(_fq));                                            \
    const int row0 = u.pm * 256 + wr * 64 + _fr, col0 = u.pn * 256 + wc * 32 + _fq * 8; \
    _Pragma("unroll") for (int ai = 0; ai < 2; ++ai)                                    \
    _Pragma("unroll") for (int m = 0; m < 4; ++m) {                                     \
      asm volatile("" ::: "memory");                                                    \
      __builtin_amdgcn_sched_barrier(0);                                                \
      const int row = row0 + ai * 128 + m * 16;                                         \
      _Pragma("unroll") for (int bj = 0; bj < 2; ++bj) {                                \
        const int col = col0 + bj * 128;                                                \
        const f32x4 v0 = acc[ai][bj][m][0], v1 = acc[ai][bj][m][1];                     \
        __VA_ARGS__                                                                     \
      }                                                                                 \
    }                                                                                   \
  }

struct EpiIn {
  static constexpr bool PERM = true, AFTER_DRAIN = false;
  float* Z; u16* G;
  __device__ __forceinline__ void operator()(const acc_t& acc, const pg8::Unit& u, int wr, int wc, int fr, int fq) const {
    if (u.pn < 11) {
      EPI_LOOP({ float* p = Z + (size_t)row * ZW + col; *(f32x4*)p = v0; *(f32x4*)(p + 4) = v1; })
    } else {
      EPI_LOOP({ *(u32x4*)(G + (size_t)row * GW + (col - ZW)) = pack8(sig4(v0), sig4(v1)); })
    }
  }
};
struct EpiLora {
  static constexpr bool PERM = true, AFTER_DRAIN = false;
  float* LO;
  __device__ __forceinline__ void operator()(const acc_t& acc, const pg8::Unit& u, int wr, int wc, int fr, int fq) const {
    EPI_LOOP({ float* p = LO + (size_t)row * LOW + col; *(f32x4*)p = v0; *(f32x4*)(p + 4) = v1; })
  }
};
template <int STAGE>
struct EpiMerge {
  static constexpr bool PERM = true, AFTER_DRAIN = false;
  const u16* Gt; float* T; u16* MG;
  __device__ __forceinline__ void operator()(const acc_t& acc, const pg8::Unit& u, int wr, int wc, int fr, int fq) const {
    EPI_LOOP({
      f32x4 g0, g1;
      unpack8(*(const u32x4*)(Gt + (size_t)row * GW + col), g0, g1);
      float* p = T + (size_t)row * DM + col;
      f32x4 a = g0 * v0, b = g1 * v1;
      if (STAGE == 0) { *(f32x4*)p = a; *(f32x4*)(p + 4) = b; }
      else if (STAGE == 1) { *(f32x4*)p = *(f32x4*)p + a; *(f32x4*)(p + 4) = *(f32x4*)(p + 4) + b; }
      else { *(u32x4*)(MG + (size_t)row * DM + col) = pack8(*(f32x4*)p + a, *(f32x4*)(p + 4) + b); }
    })
  }
};
struct EpiResid {
  static constexpr bool PERM = true, AFTER_DRAIN = false;
  float* XF;
  __device__ __forceinline__ void operator()(const acc_t& acc, const pg8::Unit& u, int wr, int wc, int fr, int fq) const {
    EPI_LOOP({ float* p = XF + (size_t)row * DM + col; *(f32x4*)p = *(f32x4*)p + v0; *(f32x4*)(p + 4) = *(f32x4*)(p + 4) + v1; })
  }
};
struct Epi13 {
  static constexpr bool PERM = true, AFTER_DRAIN = false;
  u16* HID;
  __device__ __forceinline__ void operator()(const acc_t& acc, const pg8::Unit& u, int wr, int wc, int fr, int fq) const {
    int _fr = fr, _fq = fq;
    asm volatile("" : "+v"(_fr), "+v"(_fq));
    const int row0 = u.pm * 256 + wr * 64 + _fr, col0 = u.pn * 128 + wc * 32 + _fq * 8;
#pragma unroll
    for (int ai = 0; ai < 2; ++ai)
#pragma unroll
      for (int m = 0; m < 4; ++m) {
        const int row = row0 + ai * 128 + m * 16;
        f32x4 h0, h1;
#pragma unroll
        for (int j = 0; j < 4; j++) {
          float a = acc[ai][0][m][0][j], b = acc[ai][1][m][0][j];
          h0[j] = a * sigmoidf_(a) * b;
          float c = acc[ai][0][m][1][j], d = acc[ai][1][m][1][j];
          h1[j] = c * sigmoidf_(c) * d;
        }
        *(u32x4*)(HID + (size_t)row * 2816 + col0) = pack8(h0, h1);
      }
  }
};
struct EpiPG {
  static constexpr bool PERM = true, AFTER_DRAIN = false;
  u16* PG;
  __device__ __forceinline__ void operator()(const acc_t& acc, const pg8::Unit& u, int wr, int wc, int fr, int fq) const {
    EPI_LOOP({ *(u32x4*)(PG + (size_t)row * DM + col) = pack8(sig4(v0), sig4(v1)); })
  }
};
struct EpiPP {
  static constexpr bool PERM = true, AFTER_DRAIN = false;
  const u16* PG; float* XF;
  __device__ __forceinline__ void operator()(const acc_t& acc, const pg8::Unit& u, int wr, int wc, int fr, int fq) const {
    EPI_LOOP({
      f32x4 g0, g1;
      unpack8(*(const u32x4*)(PG + (size_t)row * DM + col), g0, g1);
      float* p = XF + (size_t)row * DM + col;
      *(f32x4*)p = *(f32x4*)p + g0 * v0; *(f32x4*)(p + 4) = *(f32x4*)(p + 4) + g1 * v1;
    })
  }
};

template <class Epi>
__device__ __forceinline__ void run_gemm(char* smem, const u16* A, int lda, const u16* Bt, int ldb, int N, int K, const Epi& E) {
  pg8::Gemm g; g.A = A; g.Bt = Bt; g.M = MT; g.N = N; g.K = K; g.lda = lda; g.ldb = ldb;
  pg8::StaticOrder S; S.init(MT, N, gridDim.x, bid_());
  pg8::gemm_phase<Epi, pg8::StaticOrder, false>((PG8_LAS unsigned char*)smem, g, S, E, nullptr);
}

__device__ __forceinline__ float zs_val(const Params& P, int l, int m, int rc) {
  float zc = ((float*)(P.ws + OFF_Z))[(size_t)m * ZW + 1408 + rc];
  float prev;
  if (m < MP) {
    int t = m & 8191;
    prev = t ? ((float*)(P.ws + OFF_Z))[(size_t)(m - 1) * ZW + 1408 + rc] : 0.f;
  } else {
    int ms = m - MP;
    int t = ms & 7;
    prev = t ? ((float*)(P.ws + OFF_Z))[(size_t)(m - 1) * ZW + 1408 + rc] : P.in[3][(size_t)(l * 32 + (ms >> 3)) * 1408 + rc];
  }
  return zc + (prev - zc) * P.in[14][l * 1408 + rc];
}

__device__ __forceinline__ void phase_prep(const Params& P, int l) {
  const size_t gtid = (size_t)bid_() * NTHREADS + tid_();
  const size_t gsz = (size_t)gridDim.x * NTHREADS;
  {
    const float* Zp = ((float*)(P.ws + OFF_Z));
    u16* DPp = ((u16*)(P.ws + OFF_DP));
    for (size_t i = gtid; i < (size_t)MT * 256; i += gsz) {
      int m = (int)(i >> 8), c = (int)(i & 255);
      int w = 2 << (c >> 6);
      float vals[16];
      float cnt;
      if (m < MP) {
        int t = m & 8191;
        int n = (t + 1 < w) ? t + 1 : w;
#pragma unroll
        for (int j = 0; j < 16; j++) vals[j] = (j < n) ? Zp[(size_t)(m - j) * ZW + c] : 0.f;
        cnt = (float)n;
      } else {
        int ms = m - MP, t = ms & 7, ns = ms >> 3;
#pragma unroll
        for (int j = 0; j < 16; j++) {
          int idx = 15 + t - j;
          vals[j] = (j < w) ? ((idx >= 15) ? Zp[(size_t)(m - j) * ZW + c] : P.in[2][((size_t)(l * 32 + ns) * 15 + idx) * 256 + c]) : 0.f;
        }
        cnt = (float)w;
      }
      float s = 0.f;
#pragma unroll
      for (int j = 0; j < 16; j++) s += vals[j];
      DPp[(size_t)m * DPW + c] = f2bf(s / cnt - vals[0]);
    }
  }
  for (size_t i = gtid; i < 2 * 15 * 256; i += gsz) {
    int c = (int)(i & 255), r = (int)(i >> 8), n = r / 15, ii = r % 15;
    P.out[O_POOLP + ((size_t)(l * 2 + n) * 15 + ii) * 256 + c] = ((float*)(P.ws + OFF_Z))[(size_t)(n * 8192 + 8177 + ii) * ZW + c];
  }
  for (size_t i = gtid; i < 32 * 15 * 256; i += gsz) {
    int c = (int)(i & 255), r = (int)(i >> 8), n = r / 15, ii = r % 15;
    float v = (ii < 7) ? P.in[2][((size_t)(l * 32 + n) * 15 + 8 + ii) * 256 + c]
                       : ((float*)(P.ws + OFF_Z))[(size_t)(MP + n * 8 + (ii - 7)) * ZW + c];
    P.out[O_POOLS + ((size_t)(l * 32 + n) * 15 + ii) * 256 + c] = v;
  }
  for (size_t i = gtid; i < (size_t)MT * 192; i += gsz) {
    int m = (int)(i / 192), rr = (int)(i % 192), head = rr >> 5, fi = rr & 31;
    int gi = head >> 1, hh = head & 1;
    int W = (gi == 0) ? 128 : (gi == 1 ? 512 : 2048);
    int dil = (gi == 0) ? 1 : (gi == 1 ? 4 : 16);
    size_t offp = (gi == 0) ? O_KV128P : (gi == 1 ? O_KV512P : O_KV2048P);
    size_t offs = (gi == 0) ? O_KV128S : (gi == 1 ? O_KV512S : O_KV2048S);
    const float* z = ((float*)(P.ws + OFF_Z)) + (size_t)m * ZW;
    int pos, n, t;
    if (m < MP) { n = m >> 13; t = m & 8191; pos = t; }
    else { int ms = m - MP; n = ms >> 3; t = ms & 7; pos = 8192 + t; }
    float cs = ((float*)(P.ws + OFF_ROPE))[((size_t)pos * 32 + fi) * 2], sn = ((float*)(P.ws + OFF_ROPE))[((size_t)pos * 32 + fi) * 2 + 1];
    float q1 = z[256 + head * 64 + fi], q2 = z[256 + head * 64 + fi + 32];
    float k1 = z[640 + head * 64 + fi], k2 = z[640 + head * 64 + fi + 32];
    float v1 = z[1024 + head * 64 + fi], v2 = z[1024 + head * 64 + fi + 32];
    float qa = (q1 * cs - q2 * sn) * 0.125f, qb = (q2 * cs + q1 * sn) * 0.125f;
    float ka = k1 * cs - k2 * sn, kb = k2 * cs + k1 * sn;
    if (m < MP) {
      int L = 8192 / dil;
      int sidx = (t % dil) * L + t / dil;
      size_t base = ((size_t)(n * 6 + head) * 8192 + sidx) * 64;
      ((u16*)(P.ws + OFF_QS_))[base + fi] = f2bf(qa); ((u16*)(P.ws + OFF_QS_))[base + fi + 32] = f2bf(qb);
      ((u16*)(P.ws + OFF_KS_))[base + fi] = f2bf(ka); ((u16*)(P.ws + OFF_KS_))[base + fi + 32] = f2bf(kb);
      if (t >= 8192 - W) {
        float* o = P.out + offp + ((size_t)(l * 2 + n) * W + (t - (8192 - W))) * 256;
        o[hh * 64 + fi] = ka; o[hh * 64 + fi + 32] = kb;
        o[128 + hh * 64 + fi] = v1; o[128 + hh * 64 + fi + 32] = v2;
      }
    } else {
      int ms = m - MP;
      float* qs = ((float*)(P.ws + OFF_QSAMP)) + ((size_t)ms * 6 + head) * 64;
      qs[fi] = qa; qs[fi + 32] = qb;
      float* o = P.out + offs + ((size_t)(l * 32 + n) * W + (W - 8 + t)) * 256;
      o[hh * 64 + fi] = ka; o[hh * 64 + fi + 32] = kb;
      o[128 + hh * 64 + fi] = v1; o[128 + hh * 64 + fi + 32] = v2;
    }
  }
  for (size_t i = gtid; i < (size_t)12 * 1024 * 64; i += gsz) {
    int dd = (int)(i & 63);
    int ch = (int)((i >> 6) & 1023);
    int nh = (int)(i >> 16);
    int n = nh / 6, head = nh % 6, gi = head >> 1;
    int dil = (gi == 0) ? 1 : (gi == 1 ? 4 : 16);
    int L = 8192 / dil;
    int s0 = ch * 8;
    int r = s0 / L, l0 = s0 % L;
    unsigned w[4];
#pragma unroll
    for (int q = 0; q < 4; q++) {
      int t0 = (l0 + 2 * q) * dil + r, t1 = (l0 + 2 * q + 1) * dil + r;
      u16 a = f2bf(((float*)(P.ws + OFF_Z))[(size_t)(n * 8192 + t0) * ZW + 1024 + head * 64 + dd]);
      u16 b = f2bf(((float*)(P.ws + OFF_Z))[(size_t)(n * 8192 + t1) * ZW + 1024 + head * 64 + dd]);
      w[q] = (unsigned)a | ((unsigned)b << 16);
    }
    *(uint4*)(((u16*)(P.ws + OFF_VT)) + ((size_t)nh * 64 + dd) * 8192 + s0) = make_uint4(w[0], w[1], w[2], w[3]);
  }
  {
    u16* ALp = ((u16*)(P.ws + OFF_AL));
    batched<4, float>((size_t)MT * 256, gtid, gsz,
      [&](size_t i) { int m = (int)(i >> 8), j = (int)(i & 255); return zs_val(P, l, m, 1152 + j); },
      [&](size_t i, float zs) { int j = (int)(i & 255); float v = (j < 64) ? tanhf(zs) : (j < 128 ? zs : sigmoidf_(zs)); ALp[i] = f2bf(v); });
  }
  for (size_t i = gtid; i < 2 * 1408; i += gsz) {
    int n = (int)(i / 1408), c = (int)(i % 1408);
    P.out[O_SHIFTP + (size_t)(l * 2 + n) * 1408 + c] = ((float*)(P.ws + OFF_Z))[(size_t)(n * 8192 + 8191) * ZW + 1408 + c];
  }
  for (size_t i = gtid; i < 32 * 1408; i += gsz) {
    int n = (int)(i / 1408), c = (int)(i % 1408);
    P.out[O_SHIFTS + (size_t)(l * 32 + n) * 1408 + c] = ((float*)(P.ws + OFF_Z))[(size_t)(MP + n * 8 + 7) * ZW + 1408 + c];
  }
}

struct PrepIn { float r, k, v, wpre, apre; };
__device__ __forceinline__ PrepIn rwkv_prep_load(const Params& P, int l, int m, int C) {
  PrepIn p;
  p.r = zs_val(P, l, m, C);
  p.k = zs_val(P, l, m, 384 + C);
  p.v = zs_val(P, l, m, 768 + C);
  const float* lo = ((float*)(P.ws + OFF_LO)) + (size_t)m * LOW;
  p.wpre = lo[C]; p.apre = lo[384 + C];
  return p;
}
__device__ __forceinline__ void rwkv_prep_store(const Params& P, int l, int m, int h, int lane, PrepIn p) {
  int C = h * 64 + lane;
  float x = P.in[15][l * 384 + C] + p.wpre;
  float nx = -x;
  float sp = fmaxf(nx, 0.f) + log1pf(__expf(-fabsf(nx)));
  float wlog = -sp - 0.5f;
  float decay = __expf(-__expf(wlog));
  float a = sigmoidf_(P.in[17][l * 384 + C] + p.apre);
  float kk = p.k * P.in[20][l * 384 + C];
  float ss = wave_sum(kk * kk);
  kk *= rsqrtf(fmaxf(ss, 1e-24f));
  float k2 = p.k * (1.f + (a - 1.f) * P.in[21][l * 384 + C]);
  float bon = wave_sum(p.r * k2 * P.in[22][l * 384 + C]);
  float* sc = ((float*)(P.ws + OFF_SC)) + ((size_t)m * 6 + h) * 384;
  sc[lane] = p.r; sc[64 + lane] = decay; sc[128 + lane] = k2; sc[192 + lane] = kk; sc[256 + lane] = kk * a; sc[320 + lane] = p.v;
  if (lane == 0) ((float*)(P.ws + OFF_BON))[(size_t)m * 6 + h] = bon;
}
__device__ __forceinline__ void phase_rwkv_prep(const Params& P, int l) {
  const int lane = tid_() & 63;
  const int gw = (bid_() * NTHREADS + tid_()) >> 6;
  const int nw = gridDim.x * (NTHREADS / 64);
  for (int task = gw; task < MT * 2; task += nw) {
    int m = task >> 1, h0 = (task & 1) * 3;
    PrepIn p0 = rwkv_prep_load(P, l, m, h0 * 64 + lane);
    PrepIn p1 = rwkv_prep_load(P, l, m, (h0 + 1) * 64 + lane);
    PrepIn p2 = rwkv_prep_load(P, l, m, (h0 + 2) * 64 + lane);
    rwkv_prep_store(P, l, m, h0, lane, p0);
    rwkv_prep_store(P, l, m, h0 + 1, lane, p1);
    rwkv_prep_store(P, l, m, h0 + 2, lane, p2);
  }
}

struct FinIn { float bon, v, g; };
__device__ __forceinline__ FinIn rwkv_fin_load(const Params& P, int m, int h, int lane) {
  FinIn f;
  f.bon = ((float*)(P.ws + OFF_BON))[(size_t)m * 6 + h];
  f.v = ((float*)(P.ws + OFF_SC))[((size_t)m * 6 + h) * 384 + 320 + lane];
  f.g = ((float*)(P.ws + OFF_LO))[(size_t)m * LOW + 768 + h * 64 + lane];
  return f;
}
__device__ __forceinline__ void rwkv_fin_store(const Params& P, int m, int h, int lane, float y, FinIn f, float lng, float lnb) {
  int C = h * 64 + lane;
  float mu = wave_sum(y) * (1.f / 64.f);
  float d = y - mu;
  float var = wave_sum(d * d) * (1.f / 64.f);
  float yn = d * rsqrtf(var + 64e-5f) * lng + lnb;
  ((u16*)(P.ws + OFF_DP))[(size_t)m * DPW + 512 + C] = f2bf((yn + f.bon * f.v) * f.g);
}
__device__ __forceinline__ void rwkv_finalize(const Params& P, int l, int m, int h, int lane, float y) {
  int C = h * 64 + lane;
  FinIn f = rwkv_fin_load(P, m, h, lane);
  rwkv_fin_store(P, m, h, lane, y, f, P.in[23][l * 384 + C], P.in[24][l * 384 + C]);
}

#define CH 4
template <int KIND>
__device__ __forceinline__ void scan_wave(const Params& P, int l, int wt, float* lds) {
  const int lane = tid_() & 63;
  int m0, h, nsteps, nh = 0, seg = 0, ns = 0;
  if (KIND == 2) { ns = wt / 6; h = wt % 6; m0 = MP + ns * 8; nsteps = 8; }
  else { int g = wt >> 1; seg = g & 31; nh = g >> 5; int n = nh / 6; h = nh % 6; m0 = n * 8192 + seg * SEGLEN; nsteps = SEGLEN; }
  float S[64];
  if (KIND == 0) {
#pragma unroll
    for (int k = 0; k < 64; k++) S[k] = 0.f;
  } else if (KIND == 1) {
#pragma unroll
    for (int k = 0; k < 64; k++) S[k] = (k == lane) ? 1.f : 0.f;
  } else {
    const float4* s0 = (const float4*)(P.in[4] + (((size_t)(l * 32 + ns) * 6 + h) * 64 + lane) * 64);
#pragma unroll
    for (int k = 0; k < 16; k++) { float4 v = s0[k]; S[4 * k] = v.x; S[4 * k + 1] = v.y; S[4 * k + 2] = v.z; S[4 * k + 3] = v.w; }
  }
  f32x4 stg[6];
  const int nch = nsteps / CH;
  {
    const float* src = ((float*)(P.ws + OFF_SC)) + ((size_t)m0 * 6 + h) * 384;
#pragma unroll
    for (int q = 0; q < 6; q++) {
      int e = q * 64 + lane; int st = e / 96, w = e % 96;
      stg[q] = *(const f32x4*)(src + (size_t)st * 2304 + w * 4);
    }
  }
  for (int c = 0; c < nch; c++) {
#pragma unroll
    for (int q = 0; q < 6; q++) ((f32x4*)lds)[q * 64 + lane] = stg[q];
    if (c + 1 < nch) {
      const float* src = ((float*)(P.ws + OFF_SC)) + ((size_t)(m0 + (c + 1) * CH) * 6 + h) * 384;
#pragma unroll
      for (int q = 0; q < 6; q++) {
        int e = q * 64 + lane; int st = e / 96, w = e % 96;
        stg[q] = *(const f32x4*)(src + (size_t)st * 2304 + w * 4);
      }
    }
#pragma unroll 1
    for (int s = 0; s < CH; s++) {
      const float4* o = (const float4*)(lds + s * 384);
      const int m = m0 + c * CH + s;
      float sa = 0.f;
#pragma unroll
      for (int k = 0; k < 16; k++) {
        float4 kk = o[48 + k];
        sa -= S[4 * k] * kk.x; sa -= S[4 * k + 1] * kk.y; sa -= S[4 * k + 2] * kk.z; sa -= S[4 * k + 3] * kk.w;
      }
      float vv = 0.f;
      if (KIND != 1) vv = lds[s * 384 + 320 + lane];
      float y = 0.f;
#pragma unroll
      for (int k = 0; k < 16; k++) {
        float4 w = o[16 + k], b = o[64 + k], r = o[k];
        if (KIND != 1) {
          float4 kv = o[32 + k];
          S[4 * k] = S[4 * k] * w.x + (sa * b.x + vv * kv.x);
          S[4 * k + 1] = S[4 * k + 1] * w.y + (sa * b.y + vv * kv.y);
          S[4 * k + 2] = S[4 * k + 2] * w.z + (sa * b.z + vv * kv.z);
          S[4 * k + 3] = S[4 * k + 3] * w.w + (sa * b.w + vv * kv.w);
        } else {
          S[4 * k] = S[4 * k] * w.x + sa * b.x;
          S[4 * k + 1] = S[4 * k + 1] * w.y + sa * b.y;
          S[4 * k + 2] = S[4 * k + 2] * w.z + sa * b.z;
          S[4 * k + 3] = S[4 * k + 3] * w.w + sa * b.w;
        }
        y += S[4 * k] * r.x; y += S[4 * k + 1] * r.y; y += S[4 * k + 2] * r.z; y += S[4 * k + 3] * r.w;
      }
      if (KIND == 0) ((float*)(P.ws + OFF_YL))[(size_t)m * 384 + h * 64 + lane] = y;
      else if (KIND == 1) ((float*)(P.ws + OFF_QT))[(size_t)m * 384 + h * 64 + lane] = y;
      else rwkv_finalize(P, l, m, h, lane, y);
    }
  }
  float* dst;
  if (KIND == 0) dst = ((float*)(P.ws + OFF_LEND)) + ((size_t)(nh * NSEG + seg) * 64 + lane) * 64;
  else if (KIND == 1) dst = ((float*)(P.ws + OFF_QEND)) + ((size_t)(nh * NSEG + seg) * 64 + lane) * 64;
  else dst = P.out + O_WKVS + (((size_t)(l * 32 + ns) * 6 + h) * 64 + lane) * 64;
#pragma unroll
  for (int k = 0; k < 16; k++) ((float4*)dst)[k] = make_float4(S[4 * k], S[4 * k + 1], S[4 * k + 2], S[4 * k + 3]);
}

__device__ __forceinline__ void attn_prompt_wave(const Params& P, int task) {
  const int lane = tid_() & 63, c = lane & 31, hi = lane >> 5;
  const int qb = task & 255, nh = task >> 8;
  const int n = nh / 6, head = nh % 6, gi = head >> 1;
  const int dil = (gi == 0) ? 1 : (gi == 1 ? 4 : 16);
  const int L = 8192 / dil;
  const int sidx0 = qb * 32, r = sidx0 / L, l0 = sidx0 % L;
  const u16* Kb = ((u16*)(P.ws + OFF_KS_)) + (size_t)nh * 8192 * 64;
  const u16* Qb = ((u16*)(P.ws + OFF_QS_)) + (size_t)nh * 8192 * 64;
  const u16* Vb = ((u16*)(P.ws + OFF_VT)) + (size_t)nh * 64 * 8192;
  bf16x8 qf[4];
#pragma unroll
  for (int ch = 0; ch < 4; ch++) qf[ch] = *(const bf16x8*)(Qb + (size_t)(sidx0 + c) * 64 + ch * 16 + hi * 8);
  f32x16 o0, o1;
#pragma unroll
  for (int i = 0; i < 16; i++) { o0[i] = 0.f; o1[i] = 0.f; }
  float mrun = -INFINITY, lrun = 0.f;
  for (int kt = 0; kt < 5; kt++) {
    const int kl0 = l0 - 128 + kt * 32;
    if (kl0 < 0) continue;
    const int ks0 = r * L + kl0;
    f32x16 s;
#pragma unroll
    for (int i = 0; i < 16; i++) s[i] = 0.f;
#pragma unroll
    for (int ch = 0; ch < 4; ch++) {
      bf16x8 kf = *(const bf16x8*)(Kb + (size_t)(ks0 + c) * 64 + ch * 16 + hi * 8);
      s = __builtin_amdgcn_mfma_f32_32x32x16_bf16(kf, qf[ch], s, 0, 0, 0);
    }
    if (kt == 4) {
#pragma unroll
      for (int i = 0; i < 16; i++) { int key = (i >> 2) * 8 + hi * 4 + (i & 3); if (key > c) s[i] = -INFINITY; }
    }
    if (kt == 0) {
#pragma unroll
      for (int i = 0; i < 16; i++) { int key = (i >> 2) * 8 + hi * 4 + (i & 3); if (key < c) s[i] = -INFINITY; }
    }
    float mx = s[0];
#pragma unroll
    for (int i = 1; i < 16; i++) mx = fmaxf(mx, s[i]);
    mx = fmaxf(mx, xor32_(mx, lane));
    const float mnew = fmaxf(mrun, mx);
    const float alpha = __expf(mrun - mnew);
    float p[16];
    float ps = 0.f;
#pragma unroll
    for (int i = 0; i < 16; i++) { p[i] = __expf(s[i] - mnew); ps += p[i]; }
    ps += xor32_(ps, lane);
    lrun = lrun * alpha + ps;
    mrun = mnew;
#pragma unroll
    for (int i = 0; i < 16; i++) { o0[i] *= alpha; o1[i] *= alpha; }
#pragma unroll
    for (int j = 0; j < 2; j++) {
      bf16x8 pf;
#pragma unroll
      for (int i = 0; i < 8; i++) pf[i] = (short)f2bf(p[8 * j + i]);
#pragma unroll
      for (int dt = 0; dt < 2; dt++) {
        const u16* vp = Vb + (size_t)(dt * 32 + c) * 8192 + ks0 + 16 * j + hi * 4;
        uint2 v0 = *(const uint2*)vp;
        uint2 v1 = *(const uint2*)(vp + 8);
        union { uint4 u; bf16x8 b; } cv;
        cv.u = make_uint4(v0.x, v0.y, v1.x, v1.y);
        if (dt == 0) o0 = __builtin_amdgcn_mfma_f32_32x32x16_bf16(cv.b, pf, o0, 0, 0, 0);
        else o1 = __builtin_amdgcn_mfma_f32_32x32x16_bf16(cv.b, pf, o1, 0, 0, 0);
      }
    }
  }
  const float inv = 1.f / lrun;
  const int lq = l0 + c;
  const int t = lq * dil + r;
  const int m = n * 8192 + t;
  float* od = ((float*)(P.ws + OFF_OA)) + ((size_t)m * 6 + head) * 64;
#pragma unroll
  for (int g4 = 0; g4 < 4; g4++) {
    *(float4*)(od + g4 * 8 + hi * 4) = make_float4(o0[4 * g4] * inv, o0[4 * g4 + 1] * inv, o0[4 * g4 + 2] * inv, o0[4 * g4 + 3] * inv);
    *(float4*)(od + 32 + g4 * 8 + hi * 4) = make_float4(o1[4 * g4] * inv, o1[4 * g4 + 1] * inv, o1[4 * g4 + 2] * inv, o1[4 * g4 + 3] * inv);
  }
  if (hi == 0) ((float*)(P.ws + OFF_LSE))[(size_t)m * 6 + head] = mrun + __logf(lrun);
}

__device__ __forceinline__ void attn_sample_wave(const Params& P, int l, int task, float* lds) {
  const int lane = tid_() & 63;
  const int head = task % 6, ms = task / 6, t = ms & 7, ns = ms >> 3;
  const int gi = head >> 1, hh = head & 1;
  const int W = (gi == 0) ? 128 : (gi == 1 ? 512 : 2048);
  const int dil = (gi == 0) ? 1 : (gi == 1 ? 4 : 16);
  const size_t offs = (gi == 0) ? O_KV128S : (gi == 1 ? O_KV512S : O_KV2048S);
  const float* cache = P.in[5 + gi] + ((size_t)(l * 32 + ns) * W) * 256;
  const float* outkv = P.out + offs + ((size_t)(l * 32 + ns) * W) * 256;
  lds[lane] = ((float*)(P.ws + OFF_QSAMP))[((size_t)ms * 6 + head) * 64 + lane];
  float sc[3];
#pragma unroll
  for (int q = 0; q < 3; q++) {
    int j = lane + 64 * q;
    bool valid = (q < 2) || (lane == 0);
    int jj = valid ? j : 0;
    int idx = W + t - dil * jj;
    const float* row = (idx >= W) ? (outkv + (size_t)(idx - 8) * 256) : (cache + (size_t)idx * 256);
    const f32x4* kr = (const f32x4*)(row + hh * 64);
    float s = 0.f;
#pragma unroll
    for (int d4 = 0; d4 < 16; d4++) {
      f32x4 kv = kr[d4];
      f32x4 qv = *(const f32x4*)(lds + d4 * 4);
      s += kv[0] * qv[0] + kv[1] * qv[1] + kv[2] * qv[2] + kv[3] * qv[3];
    }
    sc[q] = valid ? s : -INFINITY;
  }
  float mx = fmaxf(sc[0], fmaxf(sc[1], sc[2]));
  {
    int iv;
#define DPP_MAX_(ctrl) iv = __builtin_amdgcn_update_dpp(0, __float_as_int(mx), ctrl, 0xF, 0xF, true); mx = fmaxf(mx, __int_as_float(iv));
    DPP_MAX_(0xB1) DPP_MAX_(0x4E) DPP_MAX_(0x141) DPP_MAX_(0x140)
#undef DPP_MAX_
    int im = __float_as_int(mx);
    float a = __int_as_float(__builtin_amdgcn_readlane(im, 0)), b = __int_as_float(__builtin_amdgcn_readlane(im, 16));
    float c = __int_as_float(__builtin_amdgcn_readlane(im, 32)), d = __int_as_float(__builtin_amdgcn_readlane(im, 48));
    mx = fmaxf(fmaxf(a, b), fmaxf(c, d));
  }
  float p0 = __expf(sc[0] - mx), p1 = __expf(sc[1] - mx), p2 = __expf(sc[2] - mx);
  float lsum = wave_sum(p0 + p1 + p2);
  lds[64 + lane] = p0; lds[128 + lane] = p1; if (lane == 0) lds[192] = p2;
  float o = 0.f;
#pragma unroll 8
  for (int j = 0; j <= 128; j++) {
    int idx = W + t - dil * j;
    const float* row = (idx >= W) ? (outkv + (size_t)(idx - 8) * 256) : (cache + (size_t)idx * 256);
    o += lds[64 + j] * row[128 + hh * 64 + lane];
  }
  const int m = MP + ms;
  ((float*)(P.ws + OFF_OA))[((size_t)m * 6 + head) * 64 + lane] = o / lsum;
  if (lane == 0) ((float*)(P.ws + OFF_LSE))[(size_t)m * 6 + head] = mx + __logf(lsum);
}

__device__ __forceinline__ void phase_scan_attn(const Params& P, int l, char* smem) {
  const int wid = tid_() >> 6;
  float* lds = (float*)smem + wid * (CH * 384);
  const int nblk = gridDim.x;
  const int bid = bid_();
  if (wid < 3) {
    for (int wt = bid * 3 + wid; wt < 768; wt += nblk * 3) {
      if (wt & 1) scan_wave<1>(P, l, wt, lds); else scan_wave<0>(P, l, wt, lds);
    }
  } else {
    const int nw = nblk * 5;
    for (int t = bid * 5 + (wid - 3); t < 192 + 3072 + 1536; t += nw) {
      if (t < 192) scan_wave<2>(P, l, t, lds);
      else if (t < 192 + 3072) attn_prompt_wave(P, t - 192);
      else attn_sample_wave(P, l, t - 192 - 3072, lds);
    }
  }
}

__device__ __forceinline__ void phase_combine(const Params& P, int l, char* smem) {
  if (bid_() < 12) {
    const int nh = bid_();
    float* sS = (float*)smem;
    float* sQ = sS + 64 * 65;
    const int tid = tid_(), v = tid >> 3, kq = tid & 7;
    f32x4 c0 = {0.f, 0.f, 0.f, 0.f}, c1 = {0.f, 0.f, 0.f, 0.f};
    const float* QE = ((float*)(P.ws + OFF_QEND)) + (size_t)nh * NSEG * 4096;
    const float* LE = ((float*)(P.ws + OFF_LEND)) + (size_t)nh * NSEG * 4096;
    float* SI = ((float*)(P.ws + OFF_SIN)) + (size_t)nh * NSEG * 4096;
    f32x4 q0 = ((const f32x4*)QE)[tid], q1 = ((const f32x4*)QE)[512 + tid];
    f32x4 n0 = *(const f32x4*)(LE + v * 64 + kq * 8), n1 = *(const f32x4*)(LE + v * 64 + kq * 8 + 4);
    for (int seg = 0; seg < NSEG; seg++) {
      float* sin = SI + (size_t)seg * 4096 + v * 64 + kq * 8;
      *(f32x4*)sin = c0; *(f32x4*)(sin + 4) = c1;
      __syncthreads();
#pragma unroll
      for (int i = 0; i < 4; i++) { sS[v * 65 + kq * 8 + i] = c0[i]; sS[v * 65 + kq * 8 + 4 + i] = c1[i]; }
      ((f32x4*)sQ)[tid] = q0;
      ((f32x4*)sQ)[512 + tid] = q1;
      f32x4 a0 = n0, a1 = n1;
      __syncthreads();
      if (seg + 1 < NSEG) {
        const float* qe = QE + (size_t)(seg + 1) * 4096;
        const float* le = LE + (size_t)(seg + 1) * 4096 + v * 64 + kq * 8;
        q0 = ((const f32x4*)qe)[tid]; q1 = ((const f32x4*)qe)[512 + tid];
        n0 = *(const f32x4*)le; n1 = *(const f32x4*)(le + 4);
      }
#pragma unroll 8
      for (int j = 0; j < 64; j++) {
        float a = sS[v * 65 + j];
        const f32x4* qr = (const f32x4*)(sQ + j * 64 + kq * 8);
        a0 += a * qr[0]; a1 += a * qr[1];
      }
      c0 = a0; c1 = a1;
    }
    float* dst = P.out + O_WKVP + (((size_t)l * 12 + nh) * 64 + v) * 64 + kq * 8;
    *(f32x4*)dst = c0; *(f32x4*)(dst + 4) = c1;
  } else {
    const size_t gtid = (size_t)(bid_() - 12) * NTHREADS + tid_();
    const size_t gsz = (size_t)(gridDim.x - 12) * NTHREADS;
    for (size_t i = gtid; i < (size_t)MT * 128; i += gsz) {
      int m = (int)(i >> 7), hh = (int)((i >> 6) & 1), dd = (int)(i & 63);
      float l0 = ((float*)(P.ws + OFF_LSE))[(size_t)m * 6 + hh], l1 = ((float*)(P.ws + OFF_LSE))[(size_t)m * 6 + 2 + hh], l2 = ((float*)(P.ws + OFF_LSE))[(size_t)m * 6 + 4 + hh];
      float mx = fmaxf(l0, fmaxf(l1, l2));
      float w0 = __expf(l0 - mx), w1 = __expf(l1 - mx), w2 = __expf(l2 - mx);
      float inv = 1.f / (w0 + w1 + w2);
      const float* oa = ((float*)(P.ws + OFF_OA)) + (size_t)m * 384;
      float y = (w0 * oa[hh * 64 + dd] + w1 * oa[(2 + hh) * 64 + dd] + w2 * oa[(4 + hh) * 64 + dd]) * inv;
      ((u16*)(P.ws + OFF_DP))[(size_t)m * DPW + 256 + hh * 64 + dd] = f2bf(y);
    }
  }
}

__device__ __forceinline__ void phase_correct(const Params& P, int l) {
  const int lane = tid_() & 63;
  const int gw = (bid_() * NTHREADS + tid_()) >> 6;
  const int nw = gridDim.x * (NTHREADS / 64);
  const float* QTp = ((float*)(P.ws + OFF_QT));
  const float* YLp = ((float*)(P.ws + OFF_YL));
  for (int task = gw; task < 12 * NSEG * 4; task += nw) {
    const int qtr = task & 3, g = task >> 2, seg = g & 31, nh = g >> 5, n = nh / 6, h = nh % 6;
    float S[64];
    const f32x4* sp = (const f32x4*)(((float*)(P.ws + OFF_SIN)) + ((size_t)(nh * NSEG + seg) * 64 + lane) * 64);
#pragma unroll
    for (int k = 0; k < 16; k++) { f32x4 v = sp[k]; S[4 * k] = v[0]; S[4 * k + 1] = v[1]; S[4 * k + 2] = v[2]; S[4 * k + 3] = v[3]; }
    const int m0 = n * 8192 + seg * SEGLEN + qtr * 64;
    const int C = h * 64 + lane;
    const float lng = P.in[23][l * 384 + C], lnb = P.in[24][l * 384 + C];
    for (int s = 0; s < 64; s += 2) {
      const int ma = m0 + s, mb = ma + 1;
      const f32x4* qa = (const f32x4*)(QTp + (size_t)ma * 384 + h * 64);
      const f32x4* qb = (const f32x4*)(QTp + (size_t)mb * 384 + h * 64);
      float ya = YLp[(size_t)ma * 384 + C], yb = YLp[(size_t)mb * 384 + C];
      FinIn fa = rwkv_fin_load(P, ma, h, lane), fb = rwkv_fin_load(P, mb, h, lane);
      float ya2 = 0.f, yb2 = 0.f;
#pragma unroll
      for (int k = 0; k < 16; k++) {
        f32x4 a4 = qa[k], b4 = qb[k];
        ya += S[4 * k] * a4[0]; ya2 += S[4 * k + 1] * a4[1]; ya += S[4 * k + 2] * a4[2]; ya2 += S[4 * k + 3] * a4[3];
        yb += S[4 * k] * b4[0]; yb2 += S[4 * k + 1] * b4[1]; yb += S[4 * k + 2] * b4[2]; yb2 += S[4 * k + 3] * b4[3];
      }
      rwkv_fin_store(P, ma, h, lane, ya + ya2, fa, lng, lnb);
      rwkv_fin_store(P, mb, h, lane, yb + yb2, fb, lng, lnb);
    }
  }
}

template <int l>
__device__ __forceinline__ void run_layer(const Params& P, char* smem, cg::grid_group& grid) {
    phase_rmsnorm(P, P.in[10] + l * DM, false);
    grid.sync();
    { EpiIn E; E.Z = ((float*)(P.ws + OFF_Z)); E.G = ((u16*)(P.ws + OFF_G)); run_gemm(smem, ((u16*)(P.ws + OFF_H)), DM, ((u16*)(P.ws + OFF_W_IN)) + (size_t)l * 5888 * 1024, 1024, 5888, 1024, E); }
    grid.sync();
    phase_prep(P, l);
    grid.sync();
    { EpiLora E; E.LO = ((float*)(P.ws + OFF_LO)); run_gemm(smem, ((u16*)(P.ws + OFF_AL)), 256, ((u16*)(P.ws + OFF_W_LORA)) + (size_t)l * LOW * 256, 256, LOW, 256, E); }
    grid.sync();
    phase_rwkv_prep(P, l);
    grid.sync();
    phase_scan_attn(P, l, smem);
    grid.sync();
    phase_combine(P, l, smem);
    grid.sync();
    phase_correct(P, l);
    grid.sync();
    {
      const u16* Wm = ((u16*)(P.ws + OFF_W_MERGE)) + (size_t)l * 1024 * DPW;
      { EpiMerge<0> E; E.Gt = ((u16*)(P.ws + OFF_G)); E.T = ((float*)(P.ws + OFF_T)); E.MG = ((u16*)(P.ws + OFF_MG)); run_gemm(smem, ((u16*)(P.ws + OFF_DP)), DPW, Wm, DPW, 1024, 256, E); }
      { EpiMerge<1> E; E.Gt = ((u16*)(P.ws + OFF_G)) + 1024; E.T = ((float*)(P.ws + OFF_T)); E.MG = ((u16*)(P.ws + OFF_MG)); run_gemm(smem, ((u16*)(P.ws + OFF_DP)) + 256, DPW, Wm + 256, DPW, 1024, 256, E); }
      { EpiMerge<2> E; E.Gt = ((u16*)(P.ws + OFF_G)) + 2048; E.T = ((float*)(P.ws + OFF_T)); E.MG = ((u16*)(P.ws + OFF_MG)); run_gemm(smem, ((u16*)(P.ws + OFF_DP)) + 512, DPW, Wm + 512, DPW, 1024, 384, E); }
    }
    grid.sync();
    { EpiResid E; E.XF = ((float*)(P.ws + OFF_XF)); run_gemm(smem, ((u16*)(P.ws + OFF_MG)), DM, ((u16*)(P.ws + OFF_W_OUT)) + (size_t)l * 1024 * 1024, 1024, 1024, 1024, E); }
    grid.sync();
    phase_rmsnorm(P, P.in[29] + l * DM, false);
    grid.sync();
    { Epi13 E; E.HID = ((u16*)(P.ws + OFF_HID)); run_gemm(smem, ((u16*)(P.ws + OFF_H)), DM, ((u16*)(P.ws + OFF_W_13)) + (size_t)l * 5632 * 1024, 1024, 5632, 1024, E); }
    grid.sync();
    { EpiResid E; E.XF = ((float*)(P.ws + OFF_XF)); run_gemm(smem, ((u16*)(P.ws + OFF_HID)), 2816, ((u16*)(P.ws + OFF_W_2)) + (size_t)l * 1024 * 2816, 2816, 1024, 2816, E); }
    grid.sync();
    phase_rmsnorm(P, P.in[33] + l * DM, false);
    grid.sync();
    { EpiPG E; E.PG = ((u16*)(P.ws + OFF_PG)); run_gemm(smem, ((u16*)(P.ws + OFF_H)), DM, ((u16*)(P.ws + OFF_W_PG)) + (size_t)l * 1024 * 1024, 1024, 1024, 1024, E); }
    { EpiPP E; E.PG = ((u16*)(P.ws + OFF_PG)); E.XF = ((float*)(P.ws + OFF_XF)); run_gemm(smem, ((u16*)(P.ws + OFF_PB)) + (size_t)l * MT * 256, 256, ((u16*)(P.ws + OFF_W_PP)) + (size_t)l * 1024 * 256, 256, 1024, 256, E); }
    grid.sync();
}

__global__ void __launch_bounds__(NTHREADS, 2) fwd_megakernel(Params P) {
  cg::grid_group grid = cg::this_grid();
  extern __shared__ __attribute__((aligned(16))) char smem[];
  phase_prep0(P, smem);
  grid.sync();
  run_layer<0>(P, smem, grid);
  run_layer<1>(P, smem, grid);
  run_layer<2>(P, smem, grid);
  run_layer<3>(P, smem, grid);
  phase_rmsnorm(P, P.in[36], true);
}

extern "C" void kernel_launch(void* const* d_in, const int* in_sizes, int n_in, void* d_out, int out_size,
                              void* d_ws, size_t ws_size, hipStream_t stream) {
  static int grid_blocks = 0;
  if (!grid_blocks) {
    int dev = 0, cus = 0, per_cu = 0;
    (void)hipGetDevice(&dev);
    (void)hipDeviceGetAttribute(&cus, hipDeviceAttributeMultiprocessorCount, dev);
    if (hipFuncSetAttribute((const void*)fwd_megakernel, hipFuncAttributeMaxDynamicSharedMemorySize, SMEM_BYTES) != hipSuccess)
      fprintf(stderr, "hipFuncSetAttribute failed\n");
    (void)hipOccupancyMaxActiveBlocksPerMultiprocessor(&per_cu, fwd_megakernel, NTHREADS, SMEM_BYTES);
    if (per_cu < 1) fprintf(stderr, "occupancy query says %d blocks/CU\n", per_cu);
    grid_blocks = cus;
  }
  Params P;
  memset(&P, 0, sizeof(P));
  for (int i = 0; i < 37; i++) P.in[i] = (const float*)d_in[i];
  P.out = (float*)d_out;
  P.ws = (char*)d_ws;
  if (WS_TOTAL > ws_size) { fprintf(stderr, "workspace too small: need %zu have %zu\n", (size_t)WS_TOTAL, ws_size); return; }
  void* args[] = {&P};
  hipError_t e = hipLaunchCooperativeKernel((void*)fwd_megakernel, dim3(grid_blocks), dim3(NTHREADS), args, SMEM_BYTES, stream);
  if (e != hipSuccess) fprintf(stderr, "cooperative launch failed: %s (grid %d)\n", hipGetErrorString(e), grid_blocks);
}
```

```cpp
#include <hip/hip_runtime.h>
#ifndef DUP
#define DUP 0
#endif
#include <hip/hip_cooperative_groups.h>
#include <cstdio>
#include <cstdint>
#include <cstring>
namespace cg = cooperative_groups;

typedef unsigned short u16;
typedef __attribute__((ext_vector_type(8))) short bf16x8;
typedef __attribute__((ext_vector_type(4))) float f32x4;
typedef __attribute__((ext_vector_type(16))) float f32x16;
typedef __attribute__((ext_vector_type(4))) unsigned u32x4;

#define DM 1024
#define MP 16384
#define MS 256
#define MT 16640
#define NMT 130
#define ZW 2816
#define GW 3072
#define NSEG 64
#define SEGLEN 128
#define NTHREADS 512
#define DPW 896
#define LOW 1280

struct Params {
  const float* in[37];
  float* out;
  char* ws;
};
constexpr size_t al256(size_t x) { return (x + 255) & ~(size_t)255; }
constexpr size_t OFF_XF = 0;
constexpr size_t OFF_H = OFF_XF + al256((size_t)MT*DM*4);
constexpr size_t OFF_Z = OFF_H + al256((size_t)MT*DM*2);
constexpr size_t OFF_G = OFF_Z + al256((size_t)MT*ZW*4);
constexpr size_t OFF_DP = OFF_G + al256((size_t)MT*GW*2);
constexpr size_t OFF_AL = OFF_DP + al256((size_t)MT*DPW*2);
constexpr size_t OFF_LO = OFF_AL + al256((size_t)MT*256*2);
constexpr size_t OFF_SC = OFF_LO + al256((size_t)MT*LOW*4);
constexpr size_t OFF_BON = OFF_SC + al256((size_t)MT*2304*4);
constexpr size_t OFF_YL = OFF_BON + al256((size_t)MT*6*4);
constexpr size_t OFF_QT = OFF_YL + al256((size_t)MP*384*4);
constexpr size_t OFF_LEND = OFF_QT + al256((size_t)MP*384*4);
constexpr size_t OFF_QEND = OFF_LEND + al256((size_t)12*NSEG*4096*4);
constexpr size_t OFF_SIN = OFF_QEND + al256((size_t)12*NSEG*4096*4);
constexpr size_t OFF_QS_ = OFF_SIN + al256((size_t)12*NSEG*4096*4);
constexpr size_t OFF_KS_ = OFF_QS_ + al256((size_t)MP*384*2);
constexpr size_t OFF_VT = OFF_KS_ + al256((size_t)MP*384*2);
constexpr size_t OFF_QSAMP = OFF_VT + al256((size_t)MP*384*2);
constexpr size_t OFF_OA = OFF_QSAMP + al256((size_t)MS*384*4);
constexpr size_t OFF_LSE = OFF_OA + al256((size_t)MT*384*4);
constexpr size_t OFF_MG = OFF_LSE + al256((size_t)MT*6*4);
constexpr size_t OFF_PB = OFF_MG + al256((size_t)MT*DM*2);
constexpr size_t OFF_ROPE = OFF_PB + al256((size_t)4*MT*256*2);
constexpr size_t OFF_W_IN = OFF_ROPE + al256((size_t)8200*64*4);
constexpr size_t OFF_W_LORA = OFF_W_IN + al256((size_t)4*5888*1024*2);
constexpr size_t OFF_W_MERGE = OFF_W_LORA + al256((size_t)4*LOW*256*2);
constexpr size_t OFF_W_OUT = OFF_W_MERGE + al256((size_t)4*1024*DPW*2);
constexpr size_t OFF_W_13 = OFF_W_OUT + al256((size_t)4*1024*1024*2);
constexpr size_t OFF_W_2 = OFF_W_13 + al256((size_t)4*5632*1024*2);
constexpr size_t OFF_W_PG = OFF_W_2 + al256((size_t)4*1024*2816*2);
constexpr size_t OFF_W_PP = OFF_W_PG + al256((size_t)4*1024*1024*2);
constexpr size_t WS_TOTAL = OFF_W_PP + al256((size_t)4*1024*256*2);
constexpr size_t OFF_HID = OFF_Z, OFF_T = OFF_Z, OFF_PG = OFF_Z + (size_t)100 * 1024 * 1024;


#define O_YP 0
#define O_YS 16777216
#define O_POOLP 17039360
#define O_POOLS 17070080
#define O_SHIFTP 17561600
#define O_SHIFTS 17572864
#define O_WKVP 17753088
#define O_WKVS 17949696
#define O_KV128P 21095424
#define O_KV128S 21357568
#define O_KV512P 25551872
#define O_KV512S 26600448
#define O_KV2048P 43377664
#define O_KV2048S 47571968

__device__ __forceinline__ int tid_() { int t = threadIdx.x; asm volatile("" : "+v"(t)); return t; }
__device__ __forceinline__ int bid_() { int b = blockIdx.x; asm volatile("" : "+s"(b)); return b; }
__device__ __forceinline__ u16 f2bf(float f) {
  unsigned u = __float_as_uint(f);
  u += 0x7fffu + ((u >> 16) & 1u);
  return (u16)(u >> 16);
}
__device__ __forceinline__ float bf2f(u16 h) { return __uint_as_float(((unsigned)h) << 16); }
__device__ __forceinline__ float sigmoidf_(float x) { return 1.f / (1.f + __expf(-x)); }
__device__ __forceinline__ float dpp_add_(float v, const int ctrl_sel) {
  int iv = __float_as_int(v), r;
  if (ctrl_sel == 0) r = __builtin_amdgcn_update_dpp(0, iv, 0xB1, 0xF, 0xF, true);
  else if (ctrl_sel == 1) r = __builtin_amdgcn_update_dpp(0, iv, 0x4E, 0xF, 0xF, true);
  else if (ctrl_sel == 2) r = __builtin_amdgcn_update_dpp(0, iv, 0x141, 0xF, 0xF, true);
  else r = __builtin_amdgcn_update_dpp(0, iv, 0x140, 0xF, 0xF, true);
  return v + __int_as_float(r);
}
__device__ __forceinline__ float wave_sum(float v) {
  v = dpp_add_(v, 0); v = dpp_add_(v, 1); v = dpp_add_(v, 2); v = dpp_add_(v, 3);
  int iv = __float_as_int(v);
  float a = __int_as_float(__builtin_amdgcn_readlane(iv, 0)), b = __int_as_float(__builtin_amdgcn_readlane(iv, 16));
  float c = __int_as_float(__builtin_amdgcn_readlane(iv, 32)), d = __int_as_float(__builtin_amdgcn_readlane(iv, 48));
  return (a + b) + (c + d);
}
__device__ __forceinline__ float xor32_(float v, int lane) {
  return __int_as_float(__builtin_amdgcn_ds_bpermute((lane ^ 32) << 2, __float_as_int(v)));
}

template <int U, class T, class LoadF, class StoreF>
__device__ __forceinline__ void batched(size_t n, size_t gtid, size_t gsz, LoadF ld, StoreF st) {
  size_t i = gtid;
  for (; i + (size_t)(U - 1) * gsz < n; i += (size_t)U * gsz) {
    T v[U];
#pragma unroll
    for (int u = 0; u < U; u++) v[u] = ld(i + (size_t)u * gsz);
#pragma unroll
    for (int u = 0; u < U; u++) st(i + (size_t)u * gsz, v[u]);
  }
  for (; i < n; i += gsz) st(i, ld(i));
}

#define LROW 72
#define SMEM_BYTES 131072
namespace pg8 {
#define PG8_LAS __attribute__((address_space(3)))
typedef unsigned short bf16_t;
constexpr int BM = 256, BK = 64, HALF = 128, HTB = HALF * BK * 2  , STAGE_BYTES = 8 * HTB, NXCD = 8, WGM = 8;

__host__ __device__ __forceinline__ int lds_byte(int r, int c) { const int st = (r >> 4) * 2 + (c >> 5), rr = r & 15, cc = c & 31, ob = rr * 64 + cc * 2; return st * 1024 + (ob ^ (((ob >> 9) & 1) << 5)); }
__host__ __device__ __forceinline__ void stage_rc(int b, int& R, int& C) { const int st = b / 1024, sb = b % 1024, swz = sb ^ (((sb >> 9) & 1) << 5); R = (st >> 1) * 16 + swz / 64; C = (st & 1) * 32 + (swz % 64) / 2; }
__host__ __device__ __forceinline__ int perm32(int rho) { const int n = rho >> 4, i = rho & 15; return 8 * (i >> 2) + 4 * n + (i & 3); }

struct Unit { int pm, pn; };
struct Gemm { const bf16_t* A; const bf16_t* Bt; int M, N, K, lda, ldb; };

struct StaticOrder {
    int nM, nN, nwg, G, c;
    __host__ __device__ void init(int M, int N, int G_, int c_) { nM = M / BM; nN = N / BM; nwg = nM * nN; G = G_; c = c_; }
    __host__ __device__ bool next(int i, Unit& u) const {
        const long L = (long)i * G + c; if (L >= nwg) return false;
        int wgid = (int)L; { const int q = nwg / NXCD, r = nwg % NXCD, xcd = wgid % NXCD, off = wgid / NXCD; wgid = (xcd < r ? xcd * (q + 1) : r * (q + 1) + (xcd - r) * q) + off; }
        const int nig = WGM * nN, gid = wgid / nig, fm = gid * WGM, gsz = (nM - fm) < WGM ? (nM - fm) : WGM;
        u.pm = fm + ((wgid % nig) % gsz); u.pn = (wgid % nig) / gsz; return true;
    }
    __device__ __forceinline__ void a_ready(const Unit&) const {}
    __device__ __forceinline__ void done(const Unit&) const {}
};
template <class Epi, class Sched, bool STAMP = false>
__device__ __forceinline__ void gemm_phase(PG8_LAS unsigned char* lds, const Gemm g, const Sched& S, const Epi& E, unsigned long long* stamps) {
    const int tid = tid_(), wid = __builtin_amdgcn_readfirstlane(tid >> 6), lane = tid & 63, wr = wid >> 2, wc = wid & 3, fr = lane & 15, fq = lane >> 4;
    const int K = g.K, nt = K / BK;

#define PG8_STAMP() do {} while (0)
    PG8_STAMP();
    unsigned voffA[2], voffB[2];
#pragma unroll
    for (int i = 0; i < 2; ++i) { int R, C; stage_rc(tid * 16 + i * 8192, R, C); const int Rb = Epi::PERM ? ((R & ~31) + perm32(R & 31)) : R;
        voffA[i] = (unsigned)(R * g.lda + C) * 2u; voffB[i] = (unsigned)(Rb * g.ldb + C) * 2u; }
    const size_t kstep = (size_t)(BK * 2);
    const size_t hstepA = (size_t)HALF * g.lda * 2, hstepB = (size_t)HALF * g.ldb * 2;
    const size_t tstepA = 2 * hstepA, tstepB = 2 * hstepB;
    const unsigned ldsw = (unsigned)wid * 1024u;
    const int aoff = lds_byte(wr * 64 + fr, fq * 8), boff = lds_byte(wc * 32 + fr, fq * 8);
#define PG8_SA(b, h) (((b) * 2 + (h)) * HTB)
#define PG8_SB(b, h) ((4 + (b) * 2 + (h)) * HTB)
#define PG8_STAGE(bufoff, gbase, voff) do { _Pragma("unroll") for (int _i = 0; _i < 2; ++_i) \
        __builtin_amdgcn_global_load_lds((const unsigned*)((const char*)(gbase) + (voff)[_i]), (PG8_LAS unsigned*)(lds + (bufoff) + ldsw + _i * 8192), 16, 0, 0); } while (0)
#define PG8_LDA(dst, b, h) do { _Pragma("unroll") for (int m = 0; m < 4; ++m) _Pragma("unroll") for (int k = 0; k < 2; ++k) dst[m][k] = *(const PG8_LAS bf16x8*)(lds + PG8_SA(b, h) + aoff + m * 2048 + k * 1024); } while (0)
#define PG8_LDB(dst, b, h) do { _Pragma("unroll") for (int n = 0; n < 2; ++n) _Pragma("unroll") for (int k = 0; k < 2; ++k) dst[n][k] = *(const PG8_LAS bf16x8*)(lds + PG8_SB(b, h) + boff + n * 2048 + k * 1024); } while (0)
#define PG8_MMA(ai, bj, At, Bt) do { __builtin_amdgcn_s_setprio(1); _Pragma("unroll") for (int m = 0; m < 4; ++m) _Pragma("unroll") for (int n = 0; n < 2; ++n) _Pragma("unroll") for (int k = 0; k < 2; ++k) \
        acc[ai][bj][m][n] = __builtin_amdgcn_mfma_f32_16x16x32_bf16(Bt[n][k], At[m][k], acc[ai][bj][m][n], 0, 0, 0); __builtin_amdgcn_s_setprio(0); } while (0)
#define PG8_WAIT_V(n) asm volatile("s_waitcnt vmcnt(" #n ")" ::: "memory")
#define PG8_WAIT_L(n) asm volatile("s_waitcnt lgkmcnt(" #n ")" ::: "memory")
#define PG8_BAR __builtin_amdgcn_s_barrier()
#define PG8_SCHED __builtin_amdgcn_sched_barrier(0)
    Unit cur, nxt; int ui = 0;
    if (!S.next(0, cur)) return;
    f32x4 acc[2][2][4][2];
#pragma unroll
    for (int a = 0; a < 2; ++a)
#pragma unroll
        for (int b = 0; b < 2; ++b)
#pragma unroll
            for (int m = 0; m < 4; ++m)
#pragma unroll
                for (int n = 0; n < 2; ++n) acc[a][b][m][n] = (f32x4){0.f, 0.f, 0.f, 0.f};
    bf16x8 At[4][2], B0[2][2], B1[2][2];
    const char* cA = (const char*)g.A + (size_t)cur.pm * tstepA; const char* cB = (const char*)g.Bt + (size_t)cur.pn * tstepB;
    S.a_ready(cur);
    PG8_STAGE(PG8_SB(0, 0), cB, voffB); PG8_STAGE(PG8_SA(0, 0), cA, voffA); PG8_STAGE(PG8_SB(0, 1), cB + hstepB, voffB); PG8_STAGE(PG8_SA(0, 1), cA + hstepA, voffA);
    if (wr == 1) PG8_BAR;
    PG8_WAIT_V(4); PG8_BAR;
    PG8_STAGE(PG8_SB(1, 0), cB + kstep, voffB); PG8_STAGE(PG8_SA(1, 0), cA + kstep, voffA); PG8_STAGE(PG8_SB(1, 1), cB + hstepB + kstep, voffB);
    PG8_WAIT_V(6); PG8_BAR;
    PG8_STAMP();
    for (;;) {
        const bool has_next = S.next(ui + 1, nxt);
        const char* nA = has_next ? (const char*)g.A + (size_t)nxt.pm * tstepA : cA; const char* nB = has_next ? (const char*)g.Bt + (size_t)nxt.pn * tstepB : cB;
#pragma unroll 1
        for (int t = 0; t < nt; t += 2) {
            const bool last = (t == nt - 2);
            const char* a1 = cA + (size_t)(t + 1) * kstep;
            const char* a2 = last ? nA : cA + (size_t)(t + 2) * kstep; const char* b2 = last ? nB : cB + (size_t)(t + 2) * kstep;
            const char* a3 = a2 + kstep; const char* b3 = b2 + kstep;
            if (last && has_next) S.a_ready(nxt);
            PG8_LDB(B0, 0, 0); PG8_SCHED; PG8_LDA(At, 0, 0); PG8_STAGE(PG8_SA(1, 1), a1 + hstepA, voffA);
            PG8_WAIT_L(8); PG8_BAR; PG8_WAIT_L(0); PG8_MMA(0, 0, At, B0); PG8_BAR; PG8_SCHED;
            PG8_LDB(B1, 0, 1); PG8_STAGE(PG8_SB(0, 0), b2, voffB);
            PG8_BAR; PG8_WAIT_L(0); PG8_MMA(0, 1, At, B1); PG8_BAR;
            PG8_LDA(At, 0, 1); PG8_STAGE(PG8_SA(0, 0), a2, voffA);
            PG8_BAR; PG8_WAIT_L(0); PG8_MMA(1, 0, At, B0); PG8_BAR; PG8_SCHED;
            PG8_STAGE(PG8_SB(0, 1), b2 + hstepB, voffB);
            PG8_WAIT_V(6); PG8_BAR; PG8_MMA(1, 1, At, B1); PG8_BAR;
            PG8_LDB(B0, 1, 0); PG8_SCHED; PG8_LDA(At, 1, 0); PG8_STAGE(PG8_SA(0, 1), a2 + hstepA, voffA);
            PG8_WAIT_L(8); PG8_BAR; PG8_WAIT_L(0); PG8_MMA(0, 0, At, B0); PG8_BAR; PG8_SCHED;
            PG8_LDB(B1, 1, 1); PG8_STAGE(PG8_SB(1, 0), b3, voffB);
            PG8_BAR; PG8_WAIT_L(0); PG8_MMA(0, 1, At, B1); PG8_BAR;
            PG8_LDA(At, 1, 1); PG8_STAGE(PG8_SA(1, 0), a3, voffA);
            PG8_BAR; PG8_WAIT_L(0); PG8_MMA(1, 0, At, B0); PG8_BAR; PG8_SCHED;
            PG8_STAGE(PG8_SB(1, 1), b3 + hstepB, voffB);
            PG8_WAIT_V(6); PG8_BAR; PG8_MMA(1, 1, At, B1); PG8_BAR;
        }
        PG8_STAMP();
        if constexpr (!Epi::AFTER_DRAIN) { E(acc, cur, wr, wc, fr, fq); S.done(cur); }
        PG8_STAMP();
        if (!has_next) break;
#pragma unroll
        for (int a = 0; a < 2; ++a)
#pragma unroll
            for (int b = 0; b < 2; ++b)
#pragma unroll
                for (int m = 0; m < 4; ++m)
#pragma unroll
                    for (int n = 0; n < 2; ++n) acc[a][b][m][n] = (f32x4){0.f, 0.f, 0.f, 0.f};
        cur = nxt; cA = nA; cB = nB; ++ui;
    }
    PG8_WAIT_V(0);
    if (wr == 0) PG8_BAR;
    PG8_BAR;
    if constexpr (Epi::AFTER_DRAIN) { E.fused(acc, cur, wr, wc, fr, fq, lds, wid, lane); S.done(cur); }
    PG8_STAMP();
#undef PG8_STAMP
#undef PG8_SA
#undef PG8_SB
#undef PG8_STAGE
#undef PG8_LDA
#undef PG8_LDB
#undef PG8_MMA
#undef PG8_WAIT_V
#undef PG8_WAIT_L
#undef PG8_BAR
#undef PG8_SCHED
}
}

#include <cstdio>
#include <ctime>
#include <cstdlib>
#include <cstring>

__device__ __forceinline__ void transpose_w(const float* src, int K, int N, u16* dst, int ldb, int koff, int mode, char* smem) {
  float* t = (float*)smem;
  const int tk = K >> 6, tn = N >> 6;
  const int tid = tid_();
  for (int tile = bid_(); tile < tk * tn; tile += gridDim.x) {
    const int k0 = (tile / tn) * 64, n0 = (tile % tn) * 64;
    __syncthreads();
#pragma unroll
    for (int p = 0; p < 2; p++) {
      int i = (tid >> 4) + 32 * p, j4 = (tid & 15) * 4;
      float4 v = *(const float4*)(src + (size_t)(k0 + i) * N + n0 + j4);
      t[i * 65 + j4] = v.x; t[i * 65 + j4 + 1] = v.y; t[i * 65 + j4 + 2] = v.z; t[i * 65 + j4 + 3] = v.w;
    }
    __syncthreads();
    {
      int n = (tid >> 3), ks = (tid & 7) * 8;
      u32x4 w;
#pragma unroll
      for (int q = 0; q < 4; q++) {
        u16 lo = f2bf(t[(ks + 2 * q) * 65 + n]);
        u16 hi = f2bf(t[(ks + 2 * q + 1) * 65 + n]);
        w[q] = (unsigned)lo | ((unsigned)hi << 16);
      }
      int gn = n0 + n;
      int row = gn;
      if (mode == 1) row = (gn >> 7) * 256 + (gn & 127);
      else if (mode == 2) row = (gn >> 7) * 256 + 128 + (gn & 127);
      *(u32x4*)(dst + (size_t)row * ldb + koff + k0 + ks) = w;
    }
  }
}

__device__ __forceinline__ void phase_prep0(const Params& P, char* smem) {
  const size_t gtid = (size_t)bid_() * NTHREADS + tid_();
  const size_t gsz = (size_t)gridDim.x * NTHREADS;
  {
    const f32x4* xp = (const f32x4*)P.in[0];
    const f32x4* xs = (const f32x4*)P.in[1];
    f32x4* xf = (f32x4*)((float*)(P.ws + OFF_XF));
    const size_t np = (size_t)MP * DM / 4, ns = (size_t)MS * DM / 4;
    batched<8, f32x4>(np + ns, gtid, gsz,
      [&](size_t i) { return (i < np) ? __builtin_nontemporal_load(xp + i) : __builtin_nontemporal_load(xs + (i - np)); },
      [&](size_t i, f32x4 v) { xf[i] = v; });
  }
  {
    const size_t per = (size_t)MT * 256 / 4;
    u16* pb = ((u16*)(P.ws + OFF_PB));
    batched<8, f32x4>(4 * per, gtid, gsz,
      [&](size_t i) {
        int l = (int)(i / per);
        size_t e = (i % per) * 4;
        return (e < (size_t)MP * 256) ? __builtin_nontemporal_load((const f32x4*)(P.in[8] + (size_t)l * MP * 256 + e))
                                      : __builtin_nontemporal_load((const f32x4*)(P.in[9] + (size_t)l * MS * 256 + (e - (size_t)MP * 256)));
      },
      [&](size_t i, f32x4 v) {
        uint2 o;
        o.x = (unsigned)f2bf(v[0]) | ((unsigned)f2bf(v[1]) << 16);
        o.y = (unsigned)f2bf(v[2]) | ((unsigned)f2bf(v[3]) << 16);
        *(uint2*)(pb + i * 4) = o;
      });
  }
  {
    for (int g = 0; g < 3; g++) {
      const int W = (g == 0) ? 128 : (g == 1 ? 512 : 2048);
      const size_t ofs = (g == 0) ? O_KV128S : (g == 1 ? O_KV512S : O_KV2048S);
      const f32x4* src = (const f32x4*)P.in[5 + g];
      f32x4* dst = (f32x4*)(P.out + ofs);
      const size_t rowsPer = (size_t)(W - 8) * 64;
      const size_t total = 128 * rowsPer;
      batched<8, f32x4>(total, gtid, gsz,
        [&](size_t i) { size_t ln = i / rowsPer, r = i % rowsPer; return __builtin_nontemporal_load(src + ln * (size_t)W * 64 + 8 * 64 + r); },
        [&](size_t i, f32x4 v) { size_t ln = i / rowsPer, r = i % rowsPer; __builtin_nontemporal_store(v, dst + ln * (size_t)W * 64 + r); });
    }
  }
  {
    for (size_t i = gtid; i < 8200 * 32; i += gsz) {
      int pos = (int)(i >> 5), fi = (int)(i & 31);
      float inv = powf(10000.0f, -2.0f * (float)fi / 64.0f);
      float ang = (float)pos * inv;
      double rev = (double)ang * 0.15915494309189533577;
      rev -= rint(rev);
      float rf = (float)rev;
      ((float*)(P.ws + OFF_ROPE))[i * 2] = __builtin_amdgcn_cosf(rf);
      ((float*)(P.ws + OFF_ROPE))[i * 2 + 1] = __builtin_amdgcn_sinf(rf);
    }
  }
  for (size_t i = gtid; i < (size_t)MT * 128; i += gsz) {
    size_t m = i >> 7, c = i & 127;
    ((u16*)(P.ws + OFF_DP))[m * DPW + 384 + c] = 0;
  }
  for (int l = 0; l < 4; l++) {
    u16* wl = ((u16*)(P.ws + OFF_W_LORA)) + (size_t)l * LOW * 256;
    const float* w2 = P.in[16] + (size_t)l * 64 * 384;
    const float* a2 = P.in[18] + (size_t)l * 64 * 384;
    const float* g2 = P.in[19] + (size_t)l * 128 * 384;
    for (size_t i = gtid; i < LOW * 256; i += gsz) {
      int k = (int)(i / LOW), n = (int)(i % LOW);
      float v = 0.f;
      if (n < 384) { if (k < 64) v = w2[k * 384 + n]; }
      else if (n < 768) { if (k >= 64 && k < 128) v = a2[(k - 64) * 384 + (n - 384)]; }
      else if (n < 1152) { if (k >= 128) v = g2[(k - 128) * 384 + (n - 768)]; }
      wl[(size_t)n * 256 + k] = f2bf(v);
    }
    u16* wm = ((u16*)(P.ws + OFF_W_MERGE)) + (size_t)l * 1024 * DPW;
    const float* wg = P.in[12] + (size_t)l * 4 * 64 * 64;
    const float* sc = P.in[13] + (size_t)l * 256;
    const float* pp = P.in[25] + (size_t)l * 256 * 1024;
    for (size_t i = gtid; i < 256 * 1024; i += gsz) {
      int k = (int)(i >> 10), n = (int)(i & 1023);
      int g = k >> 6, c = k & 63;
      float s = 0.f;
      for (int j = 0; j < 64; j++) s += wg[(g * 64 + c) * 64 + j] * sc[g * 64 + j] * pp[(size_t)(g * 64 + j) * 1024 + n];
      wm[(size_t)n * DPW + k] = f2bf(s);
    }
    for (size_t i = gtid; i < 128 * 1024; i += gsz) {
      int k = (int)(i & 127), n = (int)(i >> 7);
      wm[(size_t)n * DPW + 384 + k] = 0;
    }
  }
  for (int l = 0; l < 4; l++) {
    transpose_w(P.in[11] + (size_t)l * 1024 * 5888, 1024, 5888, ((u16*)(P.ws + OFF_W_IN)) + (size_t)l * 5888 * 1024, 1024, 0, 0, smem);
    transpose_w(P.in[26] + (size_t)l * 128 * 1024, 128, 1024, ((u16*)(P.ws + OFF_W_MERGE)) + (size_t)l * 1024 * DPW, DPW, 256, 0, smem);
    transpose_w(P.in[27] + (size_t)l * 384 * 1024, 384, 1024, ((u16*)(P.ws + OFF_W_MERGE)) + (size_t)l * 1024 * DPW, DPW, 512, 0, smem);
    transpose_w(P.in[28] + (size_t)l * 1024 * 1024, 1024, 1024, ((u16*)(P.ws + OFF_W_OUT)) + (size_t)l * 1024 * 1024, 1024, 0, 0, smem);
    transpose_w(P.in[30] + (size_t)l * 1024 * 2816, 1024, 2816, ((u16*)(P.ws + OFF_W_13)) + (size_t)l * 5632 * 1024, 1024, 0, 1, smem);
    transpose_w(P.in[31] + (size_t)l * 1024 * 2816, 1024, 2816, ((u16*)(P.ws + OFF_W_13)) + (size_t)l * 5632 * 1024, 1024, 0, 2, smem);
    transpose_w(P.in[32] + (size_t)l * 2816 * 1024, 2816, 1024, ((u16*)(P.ws + OFF_W_2)) + (size_t)l * 1024 * 2816, 2816, 0, 0, smem);
    transpose_w(P.in[35] + (size_t)l * 1024 * 1024, 1024, 1024, ((u16*)(P.ws + OFF_W_PG)) + (size_t)l * 1024 * 1024, 1024, 0, 0, smem);
    transpose_w(P.in[34] + (size_t)l * 256 * 1024, 256, 1024, ((u16*)(P.ws + OFF_W_PP)) + (size_t)l * 1024 * 256, 256, 0, 0, smem);
  }
}

__device__ __forceinline__ void phase_rmsnorm(const Params& P, const float* g, bool final_) {
  const int lane = tid_() & 63;
  const int gw = (bid_() * NTHREADS + tid_()) >> 6;
  const int nw = gridDim.x * (NTHREADS / 64);
  for (int m = gw; m < MT; m += nw) {
    const float4* x = (const float4*)(((float*)(P.ws + OFF_XF)) + (size_t)m * DM);
    float4 v[4];
    float ss = 0.f;
#pragma unroll
    for (int p = 0; p < 4; p++) {
      v[p] = x[p * 64 + lane];
      ss += v[p].x * v[p].x + v[p].y * v[p].y + v[p].z * v[p].z + v[p].w * v[p].w;
    }
    ss = wave_sum(ss);
    float rstd = rsqrtf(ss * (1.f / DM) + 1e-6f);
#pragma unroll
    for (int p = 0; p < 4; p++) {
      float4 gg = ((const float4*)g)[p * 64 + lane];
      float a = v[p].x * rstd * gg.x, b = v[p].y * rstd * gg.y, c = v[p].z * rstd * gg.z, d = v[p].w * rstd * gg.w;
      if (final_) {
        float* o = (m < MP) ? (P.out + O_YP + (size_t)m * DM) : (P.out + O_YS + (size_t)(m - MP) * DM);
        ((float4*)o)[p * 64 + lane] = make_float4(a, b, c, d);
      } else {
        uint2 o;
        o.x = (unsigned)f2bf(a) | ((unsigned)f2bf(b) << 16);
        o.y = (unsigned)f2bf(c) | ((unsigned)f2bf(d) << 16);
        ((uint2*)(((u16*)(P.ws + OFF_H)) + (size_t)m * DM))[p * 64 + lane] = o;
      }
    }
  }
}

typedef f32x4 acc_t[2][2][4][2];
__device__ __forceinline__ u32x4 pack8(f32x4 a, f32x4 b) {
  u32x4 r;
  r[0] = (unsigned)f2bf(a[0]) | ((unsigned)f2bf(a[1]) << 16);
  r[1] = (unsigned)f2bf(a[2]) | ((unsigned)f2bf(a[3]) << 16);
  r[2] = (unsigned)f2bf(b[0]) | ((unsigned)f2bf(b[1]) << 16);
  r[3] = (unsigned)f2bf(b[2]) | ((unsigned)f2bf(b[3]) << 16);
  return r;
}
__device__ __forceinline__ void unpack8(u32x4 g, f32x4& a, f32x4& b) {
  a[0] = __uint_as_float(g[0] << 16); a[1] = __uint_as_float(g[0] & 0xffff0000u);
  a[2] = __uint_as_float(g[1] << 16); a[3] = __uint_as_float(g[1] & 0xffff0000u);
  b[0] = __uint_as_float(g[2] << 16); b[1] = __uint_as_float(g[2] & 0xffff0000u);
  b[2] = __uint_as_float(g[3] << 16); b[3] = __uint_as_float(g[3] & 0xffff0000u);
}
__device__ __forceinline__ f32x4 sig4(f32x4 v) { f32x4 r; r[0] = sigmoidf_(v[0]); r[1] = sigmoidf_(v[1]); r[2] = sigmoidf_(v[2]); r[3] = sigmoidf_(v[3]); return r; }

#define EPI_LOOP(...)                                                                   \
  {                                                                                     \
    int _fr = fr, _fq = fq;                                                             \
    asm volatile("" : "+v"(_fr), "+v"(_fq));                                            \
    const int row0 = u.pm * 256 + wr * 64 + _fr, col0 = u.pn * 256 + wc * 32 + _fq * 8; \
    _Pragma("unroll") for (int ai = 0; ai < 2; ++ai)                                    \
    _Pragma("unroll") for (int m = 0; m < 4; ++m) {                                     \
      asm volatile("" ::: "memory");                                                    \
      __builtin_amdgcn_sched_barrier(0);                                                \
      const int row = row0 + ai * 128 + m * 16;                                         \
      _Pragma("unroll") for (int bj = 0; bj < 2; ++bj) {                                \
        const int col = col0 + bj * 128;                                                \
        const f32x4 v0 = acc[ai][bj][m][0], v1 = acc[ai][bj][m][1];                     \
        __VA_ARGS__                                                                     \
      }                                                                                 \
    }                                                                                   \
  }

struct EpiIn {
  static constexpr bool PERM = true, AFTER_DRAIN = false;
  float* Z; u16* G;
  __device__ __forceinline__ void operator()(const acc_t& acc, const pg8::Unit& u, int wr, int wc, int fr, int fq) const {
    if (u.pn < 11) {
      EPI_LOOP({ float* p = Z + (size_t)row * ZW + col; *(f32x4*)p = v0; *(f32x4*)(p + 4) = v1; })
    } else {
      EPI_LOOP({ *(u32x4*)(G + (size_t)row * GW + (col - ZW)) = pack8(sig4(v0), sig4(v1)); })
    }
  }
};
struct EpiLora {
  static constexpr bool PERM = true, AFTER_DRAIN = false;
  float* LO;
  __device__ __forceinline__ void operator()(const acc_t& acc, const pg8::Unit& u, int wr, int wc, int fr, int fq) const {
    EPI_LOOP({ float* p = LO + (size_t)row * LOW + col; *(f32x4*)p = v0; *(f32x4*)(p + 4) = v1; })
  }
};
template <int STAGE>
struct EpiMerge {
  static constexpr bool PERM = true, AFTER_DRAIN = false;
  const u16* Gt; float* T; u16* MG;
  __device__ __forceinline__ void operator()(const acc_t& acc, const pg8::Unit& u, int wr, int wc, int fr, int fq) const {
    EPI_LOOP({
      f32x4 g0, g1;
      unpack8(*(const u32x4*)(Gt + (size_t)row * GW + col), g0, g1);
      float* p = T + (size_t)row * DM + col;
      f32x4 a = g0 * v0, b = g1 * v1;
      if (STAGE == 0) { *(f32x4*)p = a; *(f32x4*)(p + 4) = b; }
      else if (STAGE == 1) { *(f32x4*)p = *(f32x4*)p + a; *(f32x4*)(p + 4) = *(f32x4*)(p + 4) + b; }
      else { *(u32x4*)(MG + (size_t)row * DM + col) = pack8(*(f32x4*)p + a, *(f32x4*)(p + 4) + b); }
    })
  }
};
struct EpiResid {
  static constexpr bool PERM = true, AFTER_DRAIN = false;
  float* XF;
  __device__ __forceinline__ void operator()(const acc_t& acc, const pg8::Unit& u, int wr, int wc, int fr, int fq) const {
    EPI_LOOP({ float* p = XF + (size_t)row * DM + col; *(f32x4*)p = *(f32x4*)p + v0; *(f32x4*)(p + 4) = *(f32x4*)(p + 4) + v1; })
  }
};
struct Epi13 {
  static constexpr bool PERM = true, AFTER_DRAIN = false;
  u16* HID;
  __device__ __forceinline__ void operator()(const acc_t& acc, const pg8::Unit& u, int wr, int wc, int fr, int fq) const {
    int _fr = fr, _fq = fq;
    asm volatile("" : "+v"(_fr), "+v"(_fq));
    const int row0 = u.pm * 256 + wr * 64 + _fr, col0 = u.pn * 128 + wc * 32 + _fq * 8;
#pragma unroll
    for (int ai = 0; ai < 2; ++ai)
#pragma unroll
      for (int m = 0; m < 4; ++m) {
        const int row = row0 + ai * 128 + m * 16;
        f32x4 h0, h1;
#pragma unroll
        for (int j = 0; j < 4; j++) {
          float a = acc[ai][0][m][0][j], b = acc[ai][1][m][0][j];
          h0[j] = a * sigmoidf_(a) * b;
          float c = acc[ai][0][m][1][j], d = acc[ai][1][m][1][j];
          h1[j] = c * sigmoidf_(c) * d;
        }
        *(u32x4*)(HID + (size_t)row * 2816 + col0) = pack8(h0, h1);
      }
  }
};
struct EpiPG {
  static constexpr bool PERM = true, AFTER_DRAIN = false;
  u16* PG;
  __device__ __forceinline__ void operator()(const acc_t& acc, const pg8::Unit& u, int wr, int wc, int fr, int fq) const {
    EPI_LOOP({ *(u32x4*)(PG + (size_t)row * DM + col) = pack8(sig4(v0), sig4(v1)); })
  }
};
struct EpiPP {
  static constexpr bool PERM = true, AFTER_DRAIN = false;
  const u16* PG; float* XF;
  __device__ __forceinline__ void operator()(const acc_t& acc, const pg8::Unit& u, int wr, int wc, int fr, int fq) const {
    EPI_LOOP({
      f32x4 g0, g1;
      unpack8(*(const u32x4*)(PG + (size_t)row * DM + col), g0, g1);
      float* p = XF + (size_t)row * DM + col;
      *(f32x4*)p = *(f32x4*)p + g0 * v0; *(f32x4*)(p + 4) = *(f32x4*)(p + 4) + g1 * v1;
    })
  }
};

template <class Epi>
__device__ __forceinline__ void run_gemm(char* smem, const u16* A, int lda, const u16* Bt, int ldb, int N, int K, const Epi& E) {
  pg8::Gemm g; g.A = A; g.Bt = Bt; g.M = MT; g.N = N; g.K = K; g.lda = lda; g.ldb = ldb;
  pg8::StaticOrder S; S.init(MT, N, gridDim.x, bid_());
  pg8::gemm_phase<Epi, pg8::StaticOrder, false>((PG8_LAS unsigned char*)smem, g, S, E, nullptr);
}

__device__ __forceinline__ float zs_val(const Params& P, int l, int m, int rc) {
  float zc = ((float*)(P.ws + OFF_Z))[(size_t)m * ZW + 1408 + rc];
  float prev;
  if (m < MP) {
    int t = m & 8191;
    prev = t ? ((float*)(P.ws + OFF_Z))[(size_t)(m - 1) * ZW + 1408 + rc] : 0.f;
  } else {
    int ms = m - MP;
    int t = ms & 7;
    prev = t ? ((float*)(P.ws + OFF_Z))[(size_t)(m - 1) * ZW + 1408 + rc] : P.in[3][(size_t)(l * 32 + (ms >> 3)) * 1408 + rc];
  }
  return zc + (prev - zc) * P.in[14][l * 1408 + rc];
}

__device__ __forceinline__ void phase_prep(const Params& P, int l) {
  const size_t gtid = (size_t)bid_() * NTHREADS + tid_();
  const size_t gsz = (size_t)gridDim.x * NTHREADS;
  {
    const float* Zp = ((float*)(P.ws + OFF_Z));
    u16* DPp = ((u16*)(P.ws + OFF_DP));
    for (size_t i = gtid; i < (size_t)MT * 256; i += gsz) {
      int m = (int)(i >> 8), c = (int)(i & 255);
      int w = 2 << (c >> 6);
      float vals[16];
      float cnt;
      if (m < MP) {
        int t = m & 8191;
        int n = (t + 1 < w) ? t + 1 : w;
#pragma unroll
        for (int j = 0; j < 16; j++) vals[j] = (j < n) ? Zp[(size_t)(m - j) * ZW + c] : 0.f;
        cnt = (float)n;
      } else {
        int ms = m - MP, t = ms & 7, ns = ms >> 3;
#pragma unroll
        for (int j = 0; j < 16; j++) {
          int idx = 15 + t - j;
          vals[j] = (j < w) ? ((idx >= 15) ? Zp[(size_t)(m - j) * ZW + c] : P.in[2][((size_t)(l * 32 + ns) * 15 + idx) * 256 + c]) : 0.f;
        }
        cnt = (float)w;
      }
      float s = 0.f;
#pragma unroll
      for (int j = 0; j < 16; j++) s += vals[j];
      DPp[(size_t)m * DPW + c] = f2bf(s / cnt - vals[0]);
    }
  }
  for (size_t i = gtid; i < 2 * 15 * 256; i += gsz) {
    int c = (int)(i & 255), r = (int)(i >> 8), n = r / 15, ii = r % 15;
    P.out[O_POOLP + ((size_t)(l * 2 + n) * 15 + ii) * 256 + c] = ((float*)(P.ws + OFF_Z))[(size_t)(n * 8192 + 8177 + ii) * ZW + c];
  }
  for (size_t i = gtid; i < 32 * 15 * 256; i += gsz) {
    int c = (int)(i & 255), r = (int)(i >> 8), n = r / 15, ii = r % 15;
    float v = (ii < 7) ? P.in[2][((size_t)(l * 32 + n) * 15 + 8 + ii) * 256 + c]
                       : ((float*)(P.ws + OFF_Z))[(size_t)(MP + n * 8 + (ii - 7)) * ZW + c];
    P.out[O_POOLS + ((size_t)(l * 32 + n) * 15 + ii) * 256 + c] = v;
  }
  for (size_t i = gtid; i < (size_t)MT * 192; i += gsz) {
    int m = (int)(i / 192), rr = (int)(i % 192), head = rr >> 5, fi = rr & 31;
    int gi = head >> 1, hh = head & 1;
    int W = (gi == 0) ? 128 : (gi == 1 ? 512 : 2048);
    int dil = (gi == 0) ? 1 : (gi == 1 ? 4 : 16);
    size_t offp = (gi == 0) ? O_KV128P : (gi == 1 ? O_KV512P : O_KV2048P);
    size_t offs = (gi == 0) ? O_KV128S : (gi == 1 ? O_KV512S : O_KV2048S);
    const float* z = ((float*)(P.ws + OFF_Z)) + (size_t)m * ZW;
    int pos, n, t;
    if (m < MP) { n = m >> 13; t = m & 8191; pos = t; }
    else { int ms = m - MP; n = ms >> 3; t = ms & 7; pos = 8192 + t; }
    float cs = ((float*)(P.ws + OFF_ROPE))[((size_t)pos * 32 + fi) * 2], sn = ((float*)(P.ws + OFF_ROPE))[((size_t)pos * 32 + fi) * 2 + 1];
    float q1 = z[256 + head * 64 + fi], q2 = z[256 + head * 64 + fi + 32];
    float k1 = z[640 + head * 64 + fi], k2 = z[640 + head * 64 + fi + 32];
    float v1 = z[1024 + head * 64 + fi], v2 = z[1024 + head * 64 + fi + 32];
    float qa = (q1 * cs - q2 * sn) * 0.125f, qb = (q2 * cs + q1 * sn) * 0.125f;
    float ka = k1 * cs - k2 * sn, kb = k2 * cs + k1 * sn;
    if (m < MP) {
      int L = 8192 / dil;
      int sidx = (t % dil) * L + t / dil;
      size_t base = ((size_t)(n * 6 + head) * 8192 + sidx) * 64;
      ((u16*)(P.ws + OFF_QS_))[base + fi] = f2bf(qa); ((u16*)(P.ws + OFF_QS_))[base + fi + 32] = f2bf(qb);
      ((u16*)(P.ws + OFF_KS_))[base + fi] = f2bf(ka); ((u16*)(P.ws + OFF_KS_))[base + fi + 32] = f2bf(kb);
      if (t >= 8192 - W) {
        float* o = P.out + offp + ((size_t)(l * 2 + n) * W + (t - (8192 - W))) * 256;
        o[hh * 64 + fi] = ka; o[hh * 64 + fi + 32] = kb;
        o[128 + hh * 64 + fi] = v1; o[128 + hh * 64 + fi + 32] = v2;
      }
    } else {
      int ms = m - MP;
      float* qs = ((float*)(P.ws + OFF_QSAMP)) + ((size_t)ms * 6 + head) * 64;
      qs[fi] = qa; qs[fi + 32] = qb;
      float* o = P.out + offs + ((size_t)(l * 32 + n) * W + (W - 8 + t)) * 256;
      o[hh * 64 + fi] = ka; o[hh * 64 + fi + 32] = kb;
      o[128 + hh * 64 + fi] = v1; o[128 + hh * 64 + fi + 32] = v2;
    }
  }
  for (size_t i = gtid; i < (size_t)12 * 1024 * 64; i += gsz) {
    int dd = (int)(i & 63);
    int ch = (int)((i >> 6) & 1023);
    int nh = (int)(i >> 16);
    int n = nh / 6, head = nh % 6, gi = head >> 1;
    int dil = (gi == 0) ? 1 : (gi == 1 ? 4 : 16);
    int L = 8192 / dil;
    int s0 = ch * 8;
    int r = s0 / L, l0 = s0 % L;
    unsigned w[4];
#pragma unroll
    for (int q = 0; q < 4; q++) {
      int t0 = (l0 + 2 * q) * dil + r, t1 = (l0 + 2 * q + 1) * dil + r;
      u16 a = f2bf(((float*)(P.ws + OFF_Z))[(size_t)(n * 8192 + t0) * ZW + 1024 + head * 64 + dd]);
      u16 b = f2bf(((float*)(P.ws + OFF_Z))[(size_t)(n * 8192 + t1) * ZW + 1024 + head * 64 + dd]);
      w[q] = (unsigned)a | ((unsigned)b << 16);
    }
    *(uint4*)(((u16*)(P.ws + OFF_VT)) + ((size_t)nh * 64 + dd) * 8192 + s0) = make_uint4(w[0], w[1], w[2], w[3]);
  }
  {
    u16* ALp = ((u16*)(P.ws + OFF_AL));
    batched<4, float>((size_t)MT * 256, gtid, gsz,
      [&](size_t i) { int m = (int)(i >> 8), j = (int)(i & 255); return zs_val(P, l, m, 1152 + j); },
      [&](size_t i, float zs) { int j = (int)(i & 255); float v = (j < 64) ? tanhf(zs) : (j < 128 ? zs : sigmoidf_(zs)); ALp[i] = f2bf(v); });
  }
  for (size_t i = gtid; i < 2 * 1408; i += gsz) {
    int n = (int)(i / 1408), c = (int)(i % 1408);
    P.out[O_SHIFTP + (size_t)(l * 2 + n) * 1408 + c] = ((float*)(P.ws + OFF_Z))[(size_t)(n * 8192 + 8191) * ZW + 1408 + c];
  }
  for (size_t i = gtid; i < 32 * 1408; i += gsz) {
    int n = (int)(i / 1408), c = (int)(i % 1408);
    P.out[O_SHIFTS + (size_t)(l * 32 + n) * 1408 + c] = ((float*)(P.ws + OFF_Z))[(size_t)(MP + n * 8 + 7) * ZW + 1408 + c];
  }
}

struct PrepIn { float r, k, v, wpre, apre; };
__device__ __forceinline__ PrepIn rwkv_prep_load(const Params& P, int l, int m, int C) {
  PrepIn p;
  p.r = zs_val(P, l, m, C);
  p.k = zs_val(P, l, m, 384 + C);
  p.v = zs_val(P, l, m, 768 + C);
  const float* lo = ((float*)(P.ws + OFF_LO)) + (size_t)m * LOW;
  p.wpre = lo[C]; p.apre = lo[384 + C];
  return p;
}
__device__ __forceinline__ void rwkv_prep_store(const Params& P, int l, int m, int h, int lane, PrepIn p) {
  int C = h * 64 + lane;
  float x = P.in[15][l * 384 + C] + p.wpre;
  float nx = -x;
  float sp = fmaxf(nx, 0.f) + log1pf(__expf(-fabsf(nx)));
  float wlog = -sp - 0.5f;
  float decay = __expf(-__expf(wlog));
  float a = sigmoidf_(P.in[17][l * 384 + C] + p.apre);
  float kk = p.k * P.in[20][l * 384 + C];
  float ss = wave_sum(kk * kk);
  kk *= rsqrtf(fmaxf(ss, 1e-24f));
  float k2 = p.k * (1.f + (a - 1.f) * P.in[21][l * 384 + C]);
  float bon = wave_sum(p.r * k2 * P.in[22][l * 384 + C]);
  float* sc = ((float*)(P.ws + OFF_SC)) + ((size_t)m * 6 + h) * 384;
  sc[lane] = p.r; sc[64 + lane] = decay; sc[128 + lane] = k2; sc[192 + lane] = kk; sc[256 + lane] = kk * a; sc[320 + lane] = p.v;
  if (lane == 0) ((float*)(P.ws + OFF_BON))[(size_t)m * 6 + h] = bon;
}
__device__ __forceinline__ void phase_rwkv_prep(const Params& P, int l) {
  const int lane = tid_() & 63;
  const int gw = (bid_() * NTHREADS + tid_()) >> 6;
  const int nw = gridDim.x * (NTHREADS / 64);
  for (int task = gw; task < MT * 2; task += nw) {
    int m = task >> 1, h0 = (task & 1) * 3;
    PrepIn p0 = rwkv_prep_load(P, l, m, h0 * 64 + lane);
    PrepIn p1 = rwkv_prep_load(P, l, m, (h0 + 1) * 64 + lane);
    PrepIn p2 = rwkv_prep_load(P, l, m, (h0 + 2) * 64 + lane);
    rwkv_prep_store(P, l, m, h0, lane, p0);
    rwkv_prep_store(P, l, m, h0 + 1, lane, p1);
    rwkv_prep_store(P, l, m, h0 + 2, lane, p2);
  }
}

struct FinIn { float bon, v, g; };
__device__ __forceinline__ FinIn rwkv_fin_load(const Params& P, int m, int h, int lane) {
  FinIn f;
  f.bon = ((float*)(P.ws + OFF_BON))[(size_t)m * 6 + h];
  f.v = ((float*)(P.ws + OFF_SC))[((size_t)m * 6 + h) * 384 + 320 + lane];
  f.g = ((float*)(P.ws + OFF_LO))[(size_t)m * LOW + 768 + h * 64 + lane];
  return f;
}
__device__ __forceinline__ void rwkv_fin_store(const Params& P, int m, int h, int lane, float y, FinIn f, float lng, float lnb) {
  int C = h * 64 + lane;
  float mu = wave_sum(y) * (1.f / 64.f);
  float d = y - mu;
  float var = wave_sum(d * d) * (1.f / 64.f);
  float yn = d * rsqrtf(var + 64e-5f) * lng + lnb;
  ((u16*)(P.ws + OFF_DP))[(size_t)m * DPW + 512 + C] = f2bf((yn + f.bon * f.v) * f.g);
}
__device__ __forceinline__ void rwkv_finalize(const Params& P, int l, int m, int h, int lane, float y) {
  int C = h * 64 + lane;
  FinIn f = rwkv_fin_load(P, m, h, lane);
  rwkv_fin_store(P, m, h, lane, y, f, P.in[23][l * 384 + C], P.in[24][l * 384 + C]);
}

#define CH 4
template <int KIND>
__device__ __forceinline__ void scan_wave(const Params& P, int l, int wt, float* lds) {
  const int lane = tid_() & 63;
  int m0, h, nsteps, nh = 0, seg = 0, ns = 0;
  if (KIND == 2) { ns = wt / 6; h = wt % 6; m0 = MP + ns * 8; nsteps = 8; }
  else { int g = wt >> 1; seg = g & 31; nh = g >> 5; int n = nh / 6; h = nh % 6; m0 = n * 8192 + seg * SEGLEN; nsteps = SEGLEN; }
  float S[64];
  if (KIND == 0) {
#pragma unroll
    for (int k = 0; k < 64; k++) S[k] = 0.f;
  } else if (KIND == 1) {
#pragma unroll
    for (int k = 0; k < 64; k++) S[k] = (k == lane) ? 1.f : 0.f;
  } else {
    const float4* s0 = (const float4*)(P.in[4] + (((size_t)(l * 32 + ns) * 6 + h) * 64 + lane) * 64);
#pragma unroll
    for (int k = 0; k < 16; k++) { float4 v = s0[k]; S[4 * k] = v.x; S[4 * k + 1] = v.y; S[4 * k + 2] = v.z; S[4 * k + 3] = v.w; }
  }
  f32x4 stg[6];
  const int nch = nsteps / CH;
  {
    const float* src = ((float*)(P.ws + OFF_SC)) + ((size_t)m0 * 6 + h) * 384;
#pragma unroll
    for (int q = 0; q < 6; q++) {
      int e = q * 64 + lane; int st = e / 96, w = e % 96;
      stg[q] = *(const f32x4*)(src + (size_t)st * 2304 + w * 4);
    }
  }
  for (int c = 0; c < nch; c++) {
#pragma unroll
    for (int q = 0; q < 6; q++) ((f32x4*)lds)[q * 64 + lane] = stg[q];
    if (c + 1 < nch) {
      const float* src = ((float*)(P.ws + OFF_SC)) + ((size_t)(m0 + (c + 1) * CH) * 6 + h) * 384;
#pragma unroll
      for (int q = 0; q < 6; q++) {
        int e = q * 64 + lane; int st = e / 96, w = e % 96;
        stg[q] = *(const f32x4*)(src + (size_t)st * 2304 + w * 4);
      }
    }
#pragma unroll 1
    for (int s = 0; s < CH; s++) {
      const float4* o = (const float4*)(lds + s * 384);
      const int m = m0 + c * CH + s;
      float sa = 0.f;
#pragma unroll
      for (int k = 0; k < 16; k++) {
        float4 kk = o[48 + k];
        sa -= S[4 * k] * kk.x; sa -= S[4 * k + 1] * kk.y; sa -= S[4 * k + 2] * kk.z; sa -= S[4 * k + 3] * kk.w;
      }
      float vv = 0.f;
      if (KIND != 1) vv = lds[s * 384 + 320 + lane];
      float y = 0.f;
#pragma unroll
      for (int k = 0; k < 16; k++) {
        float4 w = o[16 + k], b = o[64 + k], r = o[k];
        if (KIND != 1) {
          float4 kv = o[32 + k];
          S[4 * k] = S[4 * k] * w.x + (sa * b.x + vv * kv.x);
          S[4 * k + 1] = S[4 * k + 1] * w.y + (sa * b.y + vv * kv.y);
          S[4 * k + 2] = S[4 * k + 2] * w.z + (sa * b.z + vv * kv.z);
          S[4 * k + 3] = S[4 * k + 3] * w.w + (sa * b.w + vv * kv.w);
        } else {
          S[4 * k] = S[4 * k] * w.x + sa * b.x;
          S[4 * k + 1] = S[4 * k + 1] * w.y + sa * b.y;
          S[4 * k + 2] = S[4 * k + 2] * w.z + sa * b.z;
          S[4 * k + 3] = S[4 * k + 3] * w.w + sa * b.w;
        }
        y += S[4 * k] * r.x; y += S[4 * k + 1] * r.y; y += S[4 * k + 2] * r.z; y += S[4 * k + 3] * r.w;
      }
      if (KIND == 0) ((float*)(P.ws + OFF_YL))[(size_t)m * 384 + h * 64 + lane] = y;
      else if (KIND == 1) ((float*)(P.ws + OFF_QT))[(size_t)m * 384 + h * 64 + lane] = y;
      else rwkv_finalize(P, l, m, h, lane, y);
    }
  }
  float* dst;
  if (KIND == 0) dst = ((float*)(P.ws + OFF_LEND)) + ((size_t)(nh * NSEG + seg) * 64 + lane) * 64;
  else if (KIND == 1) dst = ((float*)(P.ws + OFF_QEND)) + ((size_t)(nh * NSEG + seg) * 64 + lane) * 64;
  else dst = P.out + O_WKVS + (((size_t)(l * 32 + ns) * 6 + h) * 64 + lane) * 64;
#pragma unroll
  for (int k = 0; k < 16; k++) ((float4*)dst)[k] = make_float4(S[4 * k], S[4 * k + 1], S[4 * k + 2], S[4 * k + 3]);
}

typedef float f32x2 __attribute__((ext_vector_type(2)));
__device__ __forceinline__ f32x2 pkfma(f32x2 a, f32x2 b, f32x2 c) { return __builtin_elementwise_fma(a, b, c); }
__device__ __forceinline__ void scan_wave_prompt(const Params& P, int g, float* lds) {
  const int lane = tid_() & 63;
  const int seg = g & (NSEG - 1), nh = g / NSEG, n = nh / 6, h = nh % 6;
  const int m0 = n * 8192 + seg * SEGLEN;
  f32x2 Sl[32], Sq[32];
#pragma unroll
  for (int k = 0; k < 32; k++) {
    Sl[k] = (f32x2){0.f, 0.f};
    Sq[k] = (f32x2){(2 * k == lane) ? 1.f : 0.f, (2 * k + 1 == lane) ? 1.f : 0.f};
  }
  f32x4 stg[6];
  float stgk;
  const int nch = SEGLEN / CH;
  const float* SCp = ((float*)(P.ws + OFF_SC));
  float* YLp = ((float*)(P.ws + OFF_YL));
  float* QTp = ((float*)(P.ws + OFF_QT));
  {
    const float* src = SCp + ((size_t)m0 * 6 + h) * 384;
#pragma unroll
    for (int q = 0; q < 6; q++) {
      int e = q * 64 + lane; int st = e / 96, w = e % 96;
      stg[q] = *(const f32x4*)(src + (size_t)st * 2304 + w * 4);
    }
    stgk = src[(size_t)CH * 2304 + 192 + lane];
  }
  float sal = 0.f, saq = -SCp[((size_t)m0 * 6 + h) * 384 + 192 + lane];
  for (int c = 0; c < nch; c++) {
#pragma unroll
    for (int q = 0; q < 6; q++) ((f32x4*)lds)[q * 64 + lane] = stg[q];
    lds[CH * 384 + lane] = stgk;
    if (c + 1 < nch) {
      const float* src = SCp + ((size_t)(m0 + (c + 1) * CH) * 6 + h) * 384;
#pragma unroll
      for (int q = 0; q < 6; q++) {
        int e = q * 64 + lane; int st = e / 96, w = e % 96;
        stg[q] = *(const f32x4*)(src + (size_t)st * 2304 + w * 4);
      }
      stgk = src[(size_t)CH * 2304 + 192 + lane];
    }
#pragma unroll 1
    for (int s = 0; s < CH; s++) {
      const f32x4* o = (const f32x4*)(lds + s * 384);
      const f32x4* on = (const f32x4*)(lds + ((s + 1 < CH) ? (s + 1) * 384 + 192 : CH * 384));
      const int m = m0 + c * CH + s;
      const float vv = lds[s * 384 + 320 + lane];
      const f32x2 sal2 = {sal, sal}, saq2 = {saq, saq}, vv2 = {vv, vv};
      f32x2 yl = {0.f, 0.f}, yq = {0.f, 0.f}, al = {0.f, 0.f}, aq = {0.f, 0.f};
      f32x4 W[2], B[2], R[2], KV[2], KN[2];
      W[0] = o[16]; B[0] = o[64]; R[0] = o[0]; KV[0] = o[32]; KN[0] = on[0];
#pragma unroll
      for (int k = 0; k < 16; k++) {
        const int cur = k & 1, nxt = cur ^ 1;
        if (k + 1 < 16) { W[nxt] = o[16 + k + 1]; B[nxt] = o[64 + k + 1]; R[nxt] = o[k + 1]; KV[nxt] = o[32 + k + 1]; KN[nxt] = on[k + 1]; }
        const f32x4 w = W[cur], b = B[cur], r = R[cur], kv = KV[cur], kn = KN[cur];
        const f32x2 w01 = {w[0], w[1]}, w23 = {w[2], w[3]}, b01 = {b[0], b[1]}, b23 = {b[2], b[3]};
        const f32x2 r01 = {r[0], r[1]}, r23 = {r[2], r[3]}, v01 = {kv[0], kv[1]}, v23 = {kv[2], kv[3]};
        const f32x2 n01 = {kn[0], kn[1]}, n23 = {kn[2], kn[3]};
        const f32x2 t0 = pkfma(sal2, b01, vv2 * v01), t1 = pkfma(sal2, b23, vv2 * v23);
        Sl[2 * k] = pkfma(Sl[2 * k], w01, t0); Sl[2 * k + 1] = pkfma(Sl[2 * k + 1], w23, t1);
        Sq[2 * k] = pkfma(Sq[2 * k], w01, saq2 * b01); Sq[2 * k + 1] = pkfma(Sq[2 * k + 1], w23, saq2 * b23);
        yl = pkfma(Sl[2 * k], r01, yl); yl = pkfma(Sl[2 * k + 1], r23, yl);
        yq = pkfma(Sq[2 * k], r01, yq); yq = pkfma(Sq[2 * k + 1], r23, yq);
        al = pkfma(Sl[2 * k], n01, al); al = pkfma(Sl[2 * k + 1], n23, al);
        aq = pkfma(Sq[2 * k], n01, aq); aq = pkfma(Sq[2 * k + 1], n23, aq);
      }
      sal = -(al[0] + al[1]); saq = -(aq[0] + aq[1]);
      YLp[(size_t)m * 384 + h * 64 + lane] = yl[0] + yl[1];
      QTp[(size_t)m * 384 + h * 64 + lane] = yq[0] + yq[1];
    }
  }
  float* dl = ((float*)(P.ws + OFF_LEND)) + ((size_t)(nh * NSEG + seg) * 64 + lane) * 64;
#pragma unroll
  for (int k = 0; k < 16; k++) ((f32x4*)dl)[k] = (f32x4){Sl[2 * k][0], Sl[2 * k][1], Sl[2 * k + 1][0], Sl[2 * k + 1][1]};
  {
    u16* dq = ((u16*)(P.ws + OFF_QEND)) + (size_t)(nh * NSEG + seg) * 4096;
    const int tj = lane >> 5, jj = lane & 31, s2 = jj >> 4, rem = jj & 15, hh = (rem >> 2) & 1, i = ((rem >> 3) << 2) | (rem & 3);
#pragma unroll
    for (int k = 0; k < 64; k++) {
      const int tk = k >> 5, r = k & 31;
      dq[(((tk * 2 + tj) * 2 + s2) * 64 + hh * 32 + r) * 8 + i] = f2bf(Sq[k >> 1][k & 1]);
    }
  }
}

__device__ __forceinline__ void attn_prompt_wave(const Params& P, int task) {
  const int lane = tid_() & 63, c = lane & 31, hi = lane >> 5;
  const int qb = task & 255, nh = task >> 8;
  const int n = nh / 6, head = nh % 6, gi = head >> 1;
  const int dil = (gi == 0) ? 1 : (gi == 1 ? 4 : 16);
  const int L = 8192 / dil;
  const int sidx0 = qb * 32, r = sidx0 / L, l0 = sidx0 % L;
  const u16* Kb = ((u16*)(P.ws + OFF_KS_)) + (size_t)nh * 8192 * 64;
  const u16* Qb = ((u16*)(P.ws + OFF_QS_)) + (size_t)nh * 8192 * 64;
  const u16* Vb = ((u16*)(P.ws + OFF_VT)) + (size_t)nh * 64 * 8192;
  bf16x8 qf[4];
#pragma unroll
  for (int ch = 0; ch < 4; ch++) qf[ch] = *(const bf16x8*)(Qb + (size_t)(sidx0 + c) * 64 + ch * 16 + hi * 8);
  f32x16 o0, o1;
#pragma unroll
  for (int i = 0; i < 16; i++) { o0[i] = 0.f; o1[i] = 0.f; }
  float mrun = -INFINITY, lrun = 0.f;
  for (int kt = 0; kt < 5; kt++) {
    const int kl0 = l0 - 128 + kt * 32;
    if (kl0 < 0) continue;
    const int ks0 = r * L + kl0;
    f32x16 s;
#pragma unroll
    for (int i = 0; i < 16; i++) s[i] = 0.f;
#pragma unroll
    for (int ch = 0; ch < 4; ch++) {
      bf16x8 kf = *(const bf16x8*)(Kb + (size_t)(ks0 + c) * 64 + ch * 16 + hi * 8);
      s = __builtin_amdgcn_mfma_f32_32x32x16_bf16(kf, qf[ch], s, 0, 0, 0);
    }
    if (kt == 4) {
#pragma unroll
      for (int i = 0; i < 16; i++) { int key = (i >> 2) * 8 + hi * 4 + (i & 3); if (key > c) s[i] = -INFINITY; }
    }
    if (kt == 0) {
#pragma unroll
      for (int i = 0; i < 16; i++) { int key = (i >> 2) * 8 + hi * 4 + (i & 3); if (key < c) s[i] = -INFINITY; }
    }
    float mx = s[0];
#pragma unroll
    for (int i = 1; i < 16; i++) mx = fmaxf(mx, s[i]);
    mx = fmaxf(mx, xor32_(mx, lane));
    const float mnew = fmaxf(mrun, mx);
    const float alpha = __expf(mrun - mnew);
    float p[16];
    float ps = 0.f;
#pragma unroll
    for (int i = 0; i < 16; i++) { p[i] = __expf(s[i] - mnew); ps += p[i]; }
    ps += xor32_(ps, lane);
    lrun = lrun * alpha + ps;
    mrun = mnew;
#pragma unroll
    for (int i = 0; i < 16; i++) { o0[i] *= alpha; o1[i] *= alpha; }
#pragma unroll
    for (int j = 0; j < 2; j++) {
      bf16x8 pf;
#pragma unroll
      for (int i = 0; i < 8; i++) pf[i] = (short)f2bf(p[8 * j + i]);
#pragma unroll
      for (int dt = 0; dt < 2; dt++) {
        const u16* vp = Vb + (size_t)(dt * 32 + c) * 8192 + ks0 + 16 * j + hi * 4;
        uint2 v0 = *(const uint2*)vp;
        uint2 v1 = *(const uint2*)(vp + 8);
        union { uint4 u; bf16x8 b; } cv;
        cv.u = make_uint4(v0.x, v0.y, v1.x, v1.y);
        if (dt == 0) o0 = __builtin_amdgcn_mfma_f32_32x32x16_bf16(cv.b, pf, o0, 0, 0, 0);
        else o1 = __builtin_amdgcn_mfma_f32_32x32x16_bf16(cv.b, pf, o1, 0, 0, 0);
      }
    }
  }
  const float inv = 1.f / lrun;
  const int lq = l0 + c;
  const int t = lq * dil + r;
  const int m = n * 8192 + t;
  float* od = ((float*)(P.ws + OFF_OA)) + ((size_t)m * 6 + head) * 64;
#pragma unroll
  for (int g4 = 0; g4 < 4; g4++) {
    *(float4*)(od + g4 * 8 + hi * 4) = make_float4(o0[4 * g4] * inv, o0[4 * g4 + 1] * inv, o0[4 * g4 + 2] * inv, o0[4 * g4 + 3] * inv);
    *(float4*)(od + 32 + g4 * 8 + hi * 4) = make_float4(o1[4 * g4] * inv, o1[4 * g4 + 1] * inv, o1[4 * g4 + 2] * inv, o1[4 * g4 + 3] * inv);
  }
  if (hi == 0) ((float*)(P.ws + OFF_LSE))[(size_t)m * 6 + head] = mrun + __logf(lrun);
}

__device__ __forceinline__ void attn_sample_wave(const Params& P, int l, int task, float* lds) {
  const int lane = tid_() & 63;
  const int head = task % 6, ms = task / 6, t = ms & 7, ns = ms >> 3;
  const int gi = head >> 1, hh = head & 1;
  const int W = (gi == 0) ? 128 : (gi == 1 ? 512 : 2048);
  const int dil = (gi == 0) ? 1 : (gi == 1 ? 4 : 16);
  const size_t offs = (gi == 0) ? O_KV128S : (gi == 1 ? O_KV512S : O_KV2048S);
  const float* cache = P.in[5 + gi] + ((size_t)(l * 32 + ns) * W) * 256;
  const float* outkv = P.out + offs + ((size_t)(l * 32 + ns) * W) * 256;
  lds[lane] = ((float*)(P.ws + OFF_QSAMP))[((size_t)ms * 6 + head) * 64 + lane];
  float sc[3];
#pragma unroll
  for (int q = 0; q < 3; q++) {
    int j = lane + 64 * q;
    bool valid = (q < 2) || (lane == 0);
    int jj = valid ? j : 0;
    int idx = W + t - dil * jj;
    const float* row = (idx >= W) ? (outkv + (size_t)(idx - 8) * 256) : (cache + (size_t)idx * 256);
    const f32x4* kr = (const f32x4*)(row + hh * 64);
    float s = 0.f;
#pragma unroll
    for (int d4 = 0; d4 < 16; d4++) {
      f32x4 kv = kr[d4];
      f32x4 qv = *(const f32x4*)(lds + d4 * 4);
      s += kv[0] * qv[0] + kv[1] * qv[1] + kv[2] * qv[2] + kv[3] * qv[3];
    }
    sc[q] = valid ? s : -INFINITY;
  }
  float mx = fmaxf(sc[0], fmaxf(sc[1], sc[2]));
  {
    int iv;
#define DPP_MAX_(ctrl) iv = __builtin_amdgcn_update_dpp(0, __float_as_int(mx), ctrl, 0xF, 0xF, true); mx = fmaxf(mx, __int_as_float(iv));
    DPP_MAX_(0xB1) DPP_MAX_(0x4E) DPP_MAX_(0x141) DPP_MAX_(0x140)
#undef DPP_MAX_
    int im = __float_as_int(mx);
    float a = __int_as_float(__builtin_amdgcn_readlane(im, 0)), b = __int_as_float(__builtin_amdgcn_readlane(im, 16));
    float c = __int_as_float(__builtin_amdgcn_readlane(im, 32)), d = __int_as_float(__builtin_amdgcn_readlane(im, 48));
    mx = fmaxf(fmaxf(a, b), fmaxf(c, d));
  }
  float p0 = __expf(sc[0] - mx), p1 = __expf(sc[1] - mx), p2 = __expf(sc[2] - mx);
  float lsum = wave_sum(p0 + p1 + p2);
  lds[64 + lane] = p0; lds[128 + lane] = p1; if (lane == 0) lds[192] = p2;
  float o = 0.f;
#pragma unroll 8
  for (int j = 0; j <= 128; j++) {
    int idx = W + t - dil * j;
    const float* row = (idx >= W) ? (outkv + (size_t)(idx - 8) * 256) : (cache + (size_t)idx * 256);
    o += lds[64 + j] * row[128 + hh * 64 + lane];
  }
  const int m = MP + ms;
  ((float*)(P.ws + OFF_OA))[((size_t)m * 6 + head) * 64 + lane] = o / lsum;
  if (lane == 0) ((float*)(P.ws + OFF_LSE))[(size_t)m * 6 + head] = mx + __logf(lsum);
}

__device__ __forceinline__ void phase_scan_attn(const Params& P, int l, char* smem) {
  const int wid = tid_() >> 6;
  float* lds = (float*)smem + wid * (CH * 384 + 64);
  const int nblk = gridDim.x;
  const int bid = bid_();
  if (wid < 3) {
    for (int g = bid * 3 + wid; g < 12 * NSEG; g += nblk * 3) scan_wave_prompt(P, g, lds);
#if DUP & 512
    for (int g = bid * 3 + wid; g < 12 * NSEG; g += nblk * 3) scan_wave_prompt(P, g, lds);
#endif
  } else {
    const int nw = nblk * 5;
#if DUP & 1024
    for (int rep = 0; rep < 2; rep++)
#endif
    for (int t = bid * 5 + (wid - 3); t < 192 + 3072 + 1536; t += nw) {
      if (t < 192) scan_wave<2>(P, l, t, lds);
      else if (t < 192 + 3072) attn_prompt_wave(P, t - 192);
      else attn_sample_wave(P, l, t - 192 - 3072, lds);
    }
  }
}

__device__ __forceinline__ void split_bf16x8(const float* x, bf16x8& hi, bf16x8& lo) {
#pragma unroll
  for (int i = 0; i < 8; i++) { u16 h = f2bf(x[i]); hi[i] = (short)h; lo[i] = (short)f2bf(x[i] - bf2f(h)); }
}
__device__ __forceinline__ void combine_wave(const Params& P, int l, int task) {
  const int lane = tid_() & 63, r = lane & 31, hh = lane >> 5;
  const int nh = task >> 1, tv = task & 1;
  const int v = tv * 32 + r;
  const u16* QE = ((u16*)(P.ws + OFF_QEND)) + (size_t)nh * NSEG * 4096;
  const float* LE = ((float*)(P.ws + OFF_LEND)) + (size_t)nh * NSEG * 4096;
  float* SI = ((float*)(P.ws + OFF_SIN)) + (size_t)nh * NSEG * 4096;
  f32x16 X0, X1;
#pragma unroll
  for (int i = 0; i < 16; i++) { X0[i] = 0.f; X1[i] = 0.f; }
  bf16x8 An[8];
#pragma unroll
  for (int f = 0; f < 8; f++) An[f] = *(const bf16x8*)(QE + (size_t)(f * 64 + lane) * 8);
  for (int seg = 0; seg < NSEG; seg++) {
    float* so = SI + (size_t)seg * 4096 + v * 64;
#pragma unroll
    for (int g4 = 0; g4 < 4; g4++) {
      *(f32x4*)(so + 8 * g4 + 4 * hh) = (f32x4){X0[4 * g4], X0[4 * g4 + 1], X0[4 * g4 + 2], X0[4 * g4 + 3]};
      *(f32x4*)(so + 32 + 8 * g4 + 4 * hh) = (f32x4){X1[4 * g4], X1[4 * g4 + 1], X1[4 * g4 + 2], X1[4 * g4 + 3]};
    }
    const float* l_ = LE + (size_t)seg * 4096 + v * 64;
    f32x4 La[4], Lb[4];
#pragma unroll
    for (int g4 = 0; g4 < 4; g4++) { La[g4] = *(const f32x4*)(l_ + 8 * g4 + 4 * hh); Lb[g4] = *(const f32x4*)(l_ + 32 + 8 * g4 + 4 * hh); }
    bf16x8 Ac[8];
#pragma unroll
    for (int f = 0; f < 8; f++) Ac[f] = An[f];
    if (seg + 1 < NSEG) {
      const u16* q_ = QE + (size_t)(seg + 1) * 4096;
#pragma unroll
      for (int f = 0; f < 8; f++) An[f] = *(const bf16x8*)(q_ + (size_t)(f * 64 + lane) * 8);
    }
    f32x16 acc0, acc1;
#pragma unroll
    for (int i = 0; i < 16; i++) { acc0[i] = 0.f; acc1[i] = 0.f; }
#pragma unroll
    for (int tj = 0; tj < 2; tj++)
#pragma unroll
      for (int s2 = 0; s2 < 2; s2++) {
        float xs[8];
#pragma unroll
        for (int i = 0; i < 8; i++) xs[i] = (tj == 0) ? X0[8 * s2 + i] : X1[8 * s2 + i];
        bf16x8 bhi, blo;
        split_bf16x8(xs, bhi, blo);
        acc0 = __builtin_amdgcn_mfma_f32_32x32x16_bf16(Ac[(0 * 2 + tj) * 2 + s2], bhi, acc0, 0, 0, 0);
        acc0 = __builtin_amdgcn_mfma_f32_32x32x16_bf16(Ac[(0 * 2 + tj) * 2 + s2], blo, acc0, 0, 0, 0);
        acc1 = __builtin_amdgcn_mfma_f32_32x32x16_bf16(Ac[(1 * 2 + tj) * 2 + s2], bhi, acc1, 0, 0, 0);
        acc1 = __builtin_amdgcn_mfma_f32_32x32x16_bf16(Ac[(1 * 2 + tj) * 2 + s2], blo, acc1, 0, 0, 0);
      }
#pragma unroll
    for (int g4 = 0; g4 < 4; g4++)
#pragma unroll
      for (int q = 0; q < 4; q++) { X0[4 * g4 + q] = acc0[4 * g4 + q] + La[g4][q]; X1[4 * g4 + q] = acc1[4 * g4 + q] + Lb[g4][q]; }
  }
  float* dst = P.out + O_WKVP + (((size_t)l * 12 + nh) * 64 + v) * 64;
#pragma unroll
  for (int g4 = 0; g4 < 4; g4++) {
    *(f32x4*)(dst + 8 * g4 + 4 * hh) = (f32x4){X0[4 * g4], X0[4 * g4 + 1], X0[4 * g4 + 2], X0[4 * g4 + 3]};
    *(f32x4*)(dst + 32 + 8 * g4 + 4 * hh) = (f32x4){X1[4 * g4], X1[4 * g4 + 1], X1[4 * g4 + 2], X1[4 * g4 + 3]};
  }
}

__device__ __forceinline__ void phase_combine(const Params& P, int l, char* smem) {
  if (bid_() < 24) {
    if ((tid_() >> 6) == 0) combine_wave(P, l, bid_());
  } else {
    const size_t gtid = (size_t)(bid_() - 24) * NTHREADS + tid_();
    const size_t gsz = (size_t)(gridDim.x - 24) * NTHREADS;
    for (size_t i = gtid; i < (size_t)MT * 128; i += gsz) {
      int m = (int)(i >> 7), hh = (int)((i >> 6) & 1), dd = (int)(i & 63);
      float l0 = ((float*)(P.ws + OFF_LSE))[(size_t)m * 6 + hh], l1 = ((float*)(P.ws + OFF_LSE))[(size_t)m * 6 + 2 + hh], l2 = ((float*)(P.ws + OFF_LSE))[(size_t)m * 6 + 4 + hh];
      float mx = fmaxf(l0, fmaxf(l1, l2));
      float w0 = __expf(l0 - mx), w1 = __expf(l1 - mx), w2 = __expf(l2 - mx);
      float inv = 1.f / (w0 + w1 + w2);
      const float* oa = ((float*)(P.ws + OFF_OA)) + (size_t)m * 384;
      float y = (w0 * oa[hh * 64 + dd] + w1 * oa[(2 + hh) * 64 + dd] + w2 * oa[(4 + hh) * 64 + dd]) * inv;
      ((u16*)(P.ws + OFF_DP))[(size_t)m * DPW + 256 + hh * 64 + dd] = f2bf(y);
    }
  }
}

__device__ __forceinline__ void phase_correct(const Params& P, int l) {
  const int lane = tid_() & 63;
  const int gw = (bid_() * NTHREADS + tid_()) >> 6;
  const int nw = gridDim.x * (NTHREADS / 64);
  const float* QTp = ((float*)(P.ws + OFF_QT));
  const float* YLp = ((float*)(P.ws + OFF_YL));
  for (int task = gw; task < 12 * NSEG * (SEGLEN / 64); task += nw) {
    const int qtr = task % (SEGLEN / 64), g = task / (SEGLEN / 64), seg = g % NSEG, nh = g / NSEG, n = nh / 6, h = nh % 6;
    float S[64];
    const f32x4* sp = (const f32x4*)(((float*)(P.ws + OFF_SIN)) + ((size_t)(nh * NSEG + seg) * 64 + lane) * 64);
#pragma unroll
    for (int k = 0; k < 16; k++) { f32x4 v = sp[k]; S[4 * k] = v[0]; S[4 * k + 1] = v[1]; S[4 * k + 2] = v[2]; S[4 * k + 3] = v[3]; }
    const int m0 = n * 8192 + seg * SEGLEN + qtr * 64;
    const int C = h * 64 + lane;
    const float lng = P.in[23][l * 384 + C], lnb = P.in[24][l * 384 + C];
    for (int s = 0; s < 64; s += 2) {
      const int ma = m0 + s, mb = ma + 1;
      const f32x4* qa = (const f32x4*)(QTp + (size_t)ma * 384 + h * 64);
      const f32x4* qb = (const f32x4*)(QTp + (size_t)mb * 384 + h * 64);
      float ya = YLp[(size_t)ma * 384 + C], yb = YLp[(size_t)mb * 384 + C];
      FinIn fa = rwkv_fin_load(P, ma, h, lane), fb = rwkv_fin_load(P, mb, h, lane);
      float ya2 = 0.f, yb2 = 0.f;
#pragma unroll
      for (int k = 0; k < 16; k++) {
        f32x4 a4 = qa[k], b4 = qb[k];
        ya += S[4 * k] * a4[0]; ya2 += S[4 * k + 1] * a4[1]; ya += S[4 * k + 2] * a4[2]; ya2 += S[4 * k + 3] * a4[3];
        yb += S[4 * k] * b4[0]; yb2 += S[4 * k + 1] * b4[1]; yb += S[4 * k + 2] * b4[2]; yb2 += S[4 * k + 3] * b4[3];
      }
      rwkv_fin_store(P, ma, h, lane, ya + ya2, fa, lng, lnb);
      rwkv_fin_store(P, mb, h, lane, yb + yb2, fb, lng, lnb);
    }
  }
}

template <int l>
__device__ __forceinline__ void run_layer(const Params& P, char* smem, cg::grid_group& grid) {
    phase_rmsnorm(P, P.in[10] + l * DM, false);
#if DUP & 256
    grid.sync();
    phase_rmsnorm(P, P.in[10] + l * DM, false);
#endif
    grid.sync();
    { EpiIn E; E.Z = ((float*)(P.ws + OFF_Z)); E.G = ((u16*)(P.ws + OFF_G)); run_gemm(smem, ((u16*)(P.ws + OFF_H)), DM, ((u16*)(P.ws + OFF_W_IN)) + (size_t)l * 5888 * 1024, 1024, 5888, 1024, E); }
#if DUP & 2
    grid.sync();
    { EpiIn E; E.Z = ((float*)(P.ws + OFF_Z)); E.G = ((u16*)(P.ws + OFF_G)); run_gemm(smem, ((u16*)(P.ws + OFF_H)), DM, ((u16*)(P.ws + OFF_W_IN)) + (size_t)l * 5888 * 1024, 1024, 5888, 1024, E); }
#endif
    grid.sync();
    phase_prep(P, l);
#if DUP & 4
    grid.sync();
    phase_prep(P, l);
#endif
    grid.sync();
    { EpiLora E; E.LO = ((float*)(P.ws + OFF_LO)); run_gemm(smem, ((u16*)(P.ws + OFF_AL)), 256, ((u16*)(P.ws + OFF_W_LORA)) + (size_t)l * LOW * 256, 256, LOW, 256, E); }
    grid.sync();
    phase_rwkv_prep(P, l);
#if DUP & 8
    grid.sync();
    phase_rwkv_prep(P, l);
#endif
    grid.sync();
    phase_scan_attn(P, l, smem);
#if DUP & 16
    grid.sync();
    phase_scan_attn(P, l, smem);
#endif
    grid.sync();
    phase_combine(P, l, smem);
#if DUP & 32
    grid.sync();
    phase_combine(P, l, smem);
#endif
    grid.sync();
    phase_correct(P, l);
#if DUP & 64
    grid.sync();
    phase_correct(P, l);
#endif
    grid.sync();
    {
      const u16* Wm = ((u16*)(P.ws + OFF_W_MERGE)) + (size_t)l * 1024 * DPW;
      { EpiMerge<0> E; E.Gt = ((u16*)(P.ws + OFF_G)); E.T = ((float*)(P.ws + OFF_T)); E.MG = ((u16*)(P.ws + OFF_MG)); run_gemm(smem, ((u16*)(P.ws + OFF_DP)), DPW, Wm, DPW, 1024, 256, E); }
      { EpiMerge<1> E; E.Gt = ((u16*)(P.ws + OFF_G)) + 1024; E.T = ((float*)(P.ws + OFF_T)); E.MG = ((u16*)(P.ws + OFF_MG)); run_gemm(smem, ((u16*)(P.ws + OFF_DP)) + 256, DPW, Wm + 256, DPW, 1024, 256, E); }
      { EpiMerge<2> E; E.Gt = ((u16*)(P.ws + OFF_G)) + 2048; E.T = ((float*)(P.ws + OFF_T)); E.MG = ((u16*)(P.ws + OFF_MG)); run_gemm(smem, ((u16*)(P.ws + OFF_DP)) + 512, DPW, Wm + 512, DPW, 1024, 384, E); }
    }
    grid.sync();
    { EpiResid E; E.XF = ((float*)(P.ws + OFF_XF)); run_gemm(smem, ((u16*)(P.ws + OFF_MG)), DM, ((u16*)(P.ws + OFF_W_OUT)) + (size_t)l * 1024 * 1024, 1024, 1024, 1024, E); }
    grid.sync();
    phase_rmsnorm(P, P.in[29] + l * DM, false);
    grid.sync();
    { Epi13 E; E.HID = ((u16*)(P.ws + OFF_HID)); run_gemm(smem, ((u16*)(P.ws + OFF_H)), DM, ((u16*)(P.ws + OFF_W_13)) + (size_t)l * 5632 * 1024, 1024, 5632, 1024, E); }
#if DUP & 128
    grid.sync();
    { Epi13 E; E.HID = ((u16*)(P.ws + OFF_HID)); run_gemm(smem, ((u16*)(P.ws + OFF_H)), DM, ((u16*)(P.ws + OFF_W_13)) + (size_t)l * 5632 * 1024, 1024, 5632, 1024, E); }
#endif
    grid.sync();
    { EpiResid E; E.XF = ((float*)(P.ws + OFF_XF)); run_gemm(smem, ((u16*)(P.ws + OFF_HID)), 2816, ((u16*)(P.ws + OFF_W_2)) + (size_t)l * 1024 * 2816, 2816, 1024, 2816, E); }
    grid.sync();
    phase_rmsnorm(P, P.in[33] + l * DM, false);
    grid.sync();
    { EpiPG E; E.PG = ((u16*)(P.ws + OFF_PG)); run_gemm(smem, ((u16*)(P.ws + OFF_H)), DM, ((u16*)(P.ws + OFF_W_PG)) + (size_t)l * 1024 * 1024, 1024, 1024, 1024, E); }
    { EpiPP E; E.PG = ((u16*)(P.ws + OFF_PG)); E.XF = ((float*)(P.ws + OFF_XF)); run_gemm(smem, ((u16*)(P.ws + OFF_PB)) + (size_t)l * MT * 256, 256, ((u16*)(P.ws + OFF_W_PP)) + (size_t)l * 1024 * 256, 256, 1024, 256, E); }
    grid.sync();
}

__global__ void __launch_bounds__(NTHREADS, 2) fwd_megakernel(Params P) {
  cg::grid_group grid = cg::this_grid();
  extern __shared__ __attribute__((aligned(16))) char smem[];
  phase_prep0(P, smem);
  grid.sync();
#if DUP & 1
  phase_prep0(P, smem);
  grid.sync();
#endif
  run_layer<0>(P, smem, grid);
  run_layer<1>(P, smem, grid);
  run_layer<2>(P, smem, grid);
  run_layer<3>(P, smem, grid);
  phase_rmsnorm(P, P.in[36], true);
}

extern "C" void kernel_launch(void* const* d_in, const int* in_sizes, int n_in, void* d_out, int out_size,
                              void* d_ws, size_t ws_size, hipStream_t stream) {
  static int grid_blocks = 0;
  if (!grid_blocks) {
    int dev = 0, cus = 0, per_cu = 0;
    (void)hipGetDevice(&dev);
    (void)hipDeviceGetAttribute(&cus, hipDeviceAttributeMultiprocessorCount, dev);
    if (hipFuncSetAttribute((const void*)fwd_megakernel, hipFuncAttributeMaxDynamicSharedMemorySize, SMEM_BYTES) != hipSuccess)
      fprintf(stderr, "hipFuncSetAttribute failed\n");
    (void)hipOccupancyMaxActiveBlocksPerMultiprocessor(&per_cu, fwd_megakernel, NTHREADS, SMEM_BYTES);
    if (per_cu < 1) fprintf(stderr, "occupancy query says %d blocks/CU\n", per_cu);
    grid_blocks = cus;
  }
  Params P;
  memset(&P, 0, sizeof(P));
  for (int i = 0; i < 37; i++) P.in[i] = (const float*)d_in[i];
  P.out = (float*)d_out;
  P.ws = (char*)d_ws;
  if (WS_TOTAL > ws_size) { fprintf(stderr, "workspace too small: need %zu have %zu\n", (size_t)WS_TOTAL, ws_size); return; }
  void* args[] = {&P};
  hipError_t e = hipLaunchCooperativeKernel((void*)fwd_megakernel, dim3(grid_blocks), dim3(NTHREADS), args, SMEM_BYTES, stream);
  if (e != hipSuccess) fprintf(stderr, "cooperative launch failed: %s (grid %d)\n", hipGetErrorString(e), grid_blocks);
}
```
